# Optimizing an MI355X kernel written in HIP

```python
import math
import jax, jax.numpy as jnp
from jax import lax
import numpy as np

D_MODEL = 2048
BATCH = 4
SEQ = 2048
DEPTH = 1

RET_HEAD_DIM = 128
RET_HEADS = (D_MODEL // 2) // RET_HEAD_DIM
RET_WIDTH = RET_HEADS * RET_HEAD_DIM
LRU_WIDTH = D_MODEL - RET_WIDTH
LRU_BLOCKS = 8
LRU_BLOCK_DIM = LRU_WIDTH // LRU_BLOCKS
IN_COLS = 4 * RET_WIDTH + 2 * LRU_WIDTH
CONV_WIDTH = 4
LRU_C = 8.0
CHUNK = 128
ROPE_BASE = 10000.0
N_EXPERTS = 32
TOP_K = 4
D_EXPERT = D_MODEL
SWIGLU_LIMIT = 7.0
SWIGLU_ALPHA = 1.702
PLE_DIM = 256
EXPERT_BLOCK = 128
LN_EPS = 1e-5
DN_ALPHA = (2.0 * DEPTH) ** 0.25
DN_BETA = (8.0 * DEPTH) ** -0.25

kernel_name = 'hymba_retnet_rglru_moe_deepnorm_ple'


def layer_norm(x, w, b):
    x32 = x.astype(jnp.float32)
    mu = jnp.mean(x32, axis=-1, keepdims=True)
    var = jnp.mean(jnp.square(x32 - mu), axis=-1, keepdims=True)
    return (x32 - mu) * lax.rsqrt(var + LN_EPS) * w.astype(jnp.float32) + b.astype(jnp.float32)


def rms_norm(x, w):
    x32 = x.astype(jnp.float32)
    return x32 * lax.rsqrt(jnp.mean(jnp.square(x32), axis=-1, keepdims=True) + LN_EPS) * w.astype(jnp.float32)


def rope(x, pos):
    d = x.shape[-1]
    inv = ROPE_BASE ** (-jnp.arange(0, d, 2, dtype=jnp.float32) / d)
    ang = pos[:, None] * inv[None, :]
    cos = jnp.cos(ang)[:, None, :]
    sin = jnp.sin(ang)[:, None, :]
    x1, x2 = x[..., : d // 2], x[..., d // 2:]
    return jnp.concatenate([x1 * cos - x2 * sin, x1 * sin + x2 * cos], axis=-1)


def retention(q, k, v):
    b, s, h, d = q.shape
    n = s // CHUNK
    log_gamma = jnp.log1p(-jnp.exp2(-5.0 - jnp.arange(h, dtype=jnp.float32)))
    idx = jnp.arange(CHUNK, dtype=jnp.float32)
    diff = idx[:, None] - idx[None, :]
    decay_intra = jnp.where((diff >= 0)[None],
                            jnp.exp(jnp.maximum(diff, 0.0)[None] * log_gamma[:, None, None]), 0.0)
    q_dec = jnp.exp((idx[:, None] + 1.0) * log_gamma[None, :])
    k_dec = jnp.exp((CHUNK - 1.0 - idx)[:, None] * log_gamma[None, :])
    chunk_dec = jnp.exp(CHUNK * log_gamma)
    qc = q.reshape(b, n, CHUNK, h, d)
    kc = k.reshape(b, n, CHUNK, h, d)
    vc = v.reshape(b, n, CHUNK, h, d)
    scores = jnp.einsum('bnihd,bnjhd->bnhij', qc, kc) * decay_intra
    intra = jnp.einsum('bnhij,bnjhd->bnihd', scores, vc)
    kv = jnp.einsum('bnjhd,bnjhe->nbhde', kc * k_dec[:, :, None], vc)

    def step(state, kv_n):
        return chunk_dec[None, :, None, None] * state + kv_n, state

    _, prev = lax.scan(step, jnp.zeros((b, h, d, d), jnp.float32), kv)
    cross = jnp.einsum('bnihd,nbhde->bnihe', qc * q_dec[:, :, None], prev)
    return (intra + cross).reshape(b, s, h, d)


def causal_depthwise_conv(x, w, bias):
    s = x.shape[1]
    xp = jnp.pad(x, ((0, 0), (CONV_WIDTH - 1, 0), (0, 0)))
    out = bias.astype(jnp.float32)
    for j in range(CONV_WIDTH):
        out = out + xp[:, j:j + s] * w[j]
    return out


def rg_lru(x, w_a, b_a, w_x, b_x, lam):
    bsz, s, c = x.shape
    xb = x.reshape(bsz, s, LRU_BLOCKS, LRU_BLOCK_DIM)
    r = jax.nn.sigmoid(jnp.einsum('bshi,hij->bshj', xb, w_a) + b_a).reshape(bsz, s, c)
    gi = jax.nn.sigmoid(jnp.einsum('bshi,hij->bshj', xb, w_x) + b_x).reshape(bsz, s, c)
    log_a = LRU_C * r * jax.nn.log_sigmoid(lam.astype(jnp.float32))
    a = jnp.exp(log_a)
    bx = jnp.sqrt(-jnp.expm1(2.0 * log_a)) * (gi * x)

    def combine(left, right):
        a1, b1 = left
        a2, b2 = right
        return a1 * a2, a2 * b1 + b2

    _, h = lax.associative_scan(combine, (a, bx), axis=1)
    return h


def hybrid_mixer(x, w_in, ret_gn_w, conv_w, conv_b, lru_wa, lru_ba, lru_wx, lru_bx, lru_lam, w_out):
    bsz, s, _ = x.shape
    proj = jnp.einsum('bsd,de->bse', x, w_in).astype(jnp.float32)
    R = RET_WIDTH
    q, k, v, g, xr, yg = jnp.split(proj, [R, 2 * R, 3 * R, 4 * R, 4 * R + LRU_WIDTH], axis=-1)
    pos = jnp.arange(s, dtype=jnp.float32)
    q = rope(q.reshape(bsz, s, RET_HEADS, RET_HEAD_DIM), pos)
    k = rope(k.reshape(bsz, s, RET_HEADS, RET_HEAD_DIM), pos) * (RET_HEAD_DIM ** -0.5)
    ret = retention(q, k, v.reshape(bsz, s, RET_HEADS, RET_HEAD_DIM))
    mu = jnp.mean(ret, axis=-1, keepdims=True)
    var = jnp.mean(jnp.square(ret - mu), axis=-1, keepdims=True)
    ret = ((ret - mu) * lax.rsqrt(var + LN_EPS)).reshape(bsz, s, R) * ret_gn_w.astype(jnp.float32)
    ret_out = jax.nn.silu(g) * ret
    xr = causal_depthwise_conv(xr, conv_w.astype(jnp.float32), conv_b)
    h = rg_lru(xr, lru_wa.astype(jnp.float32), lru_ba.astype(jnp.float32),
               lru_wx.astype(jnp.float32), lru_bx.astype(jnp.float32), lru_lam)
    lru_out = jax.nn.gelu(yg) * h
    mixed = jnp.concatenate([ret_out, lru_out], axis=-1)
    return jnp.einsum('bse,ed->bsd', mixed, w_out.astype(jnp.float32))


def moe(x, w_router, b_router, w_gate, b_gate, w_up, b_up, w_down, b_down):
    bsz, s, d = x.shape
    t = bsz * s
    xf = x.reshape(t, d).astype(jnp.float32)
    logits = xf @ w_router.astype(jnp.float32) + b_router.astype(jnp.float32)
    top_logit, top_e = lax.top_k(logits, TOP_K)
    gates = jax.nn.softmax(top_logit, axis=-1)
    n_assign = t * TOP_K
    flat_e = top_e.reshape(-1).astype(jnp.int32)
    flat_tok = jnp.arange(n_assign, dtype=jnp.int32) // TOP_K
    flat_gate = gates.reshape(-1)
    order = jnp.argsort(flat_e)
    se, stok, sgate = flat_e[order], flat_tok[order], flat_gate[order]
    counts = jnp.zeros((N_EXPERTS,), jnp.int32).at[flat_e].add(1)
    starts = jnp.cumsum(counts) - counts
    padded = (counts + EXPERT_BLOCK - 1) // EXPERT_BLOCK * EXPERT_BLOCK
    pad_ends = jnp.cumsum(padded)
    pad_starts = pad_ends - padded
    dest = pad_starts[se] + (jnp.arange(n_assign, dtype=jnp.int32) - starts[se])
    n_pad = n_assign + N_EXPERTS * EXPERT_BLOCK
    n_blocks = n_pad // EXPERT_BLOCK
    buf_tok = jnp.full((n_pad,), t, jnp.int32).at[dest].set(stok)
    buf_gate = jnp.zeros((n_pad,), jnp.float32).at[dest].set(sgate)
    block_start = jnp.arange(n_blocks, dtype=jnp.int32) * EXPERT_BLOCK
    block_e = jnp.minimum(jnp.searchsorted(pad_ends, block_start, side='right'), N_EXPERTS - 1)
    xpad = jnp.concatenate([xf, jnp.zeros((1, d), jnp.float32)], axis=0)
    xb = xpad[buf_tok].reshape(n_blocks, EXPERT_BLOCK, d)

    def expert_block(args):
        xblk, e = args
        gt = xblk @ w_gate[e].astype(jnp.float32) + b_gate[e].astype(jnp.float32)
        up = xblk @ w_up[e].astype(jnp.float32) + b_up[e].astype(jnp.float32)
        gt = jnp.minimum(gt, SWIGLU_LIMIT)
        up = jnp.clip(up, -SWIGLU_LIMIT, SWIGLU_LIMIT)
        hid = (up + 1.0) * gt * jax.nn.sigmoid(SWIGLU_ALPHA * gt)
        return hid @ w_down[e].astype(jnp.float32) + b_down[e].astype(jnp.float32)

    yb = lax.map(expert_block, (xb, block_e)).reshape(n_pad, d)
    out = jnp.zeros((t + 1, d), jnp.float32).at[buf_tok].add(yb * buf_gate[:, None])
    return out[:t].reshape(bsz, s, d)


def setup_inputs(seed: int = 0) -> dict:
    key = jax.random.key(seed)
    ks = jax.random.split(key, 32)
    f32 = jnp.float32
    nrm = lambda k, shape, scale: jax.random.normal(k, shape, f32) * scale
    col_scale = jnp.concatenate([jnp.ones((2 * RET_WIDTH,), f32),
                                 jnp.full((RET_WIDTH,), DN_BETA, f32),
                                 jnp.ones((RET_WIDTH + 2 * LRU_WIDTH,), f32)])
    lam_u = jax.random.uniform(ks[9], (DEPTH, LRU_WIDTH), f32, 0.9, 0.999)
    lam_a = lam_u ** (1.0 / LRU_C)
    return {
        'x': nrm(ks[0], (BATCH, SEQ, D_MODEL), 1.0),
        'p': nrm(ks[1], (DEPTH, BATCH, SEQ, PLE_DIM), 1.0),
        'w_in': nrm(ks[2], (DEPTH, D_MODEL, IN_COLS), D_MODEL ** -0.5) * col_scale,
        'ret_gn_w': 1.0 + nrm(ks[3], (DEPTH, RET_WIDTH), 0.02),
        'conv_w': nrm(ks[4], (DEPTH, CONV_WIDTH, LRU_WIDTH), CONV_WIDTH ** -0.5),
        'conv_b': nrm(ks[5], (DEPTH, LRU_WIDTH), 0.01),
        'lru_wa': nrm(ks[6], (DEPTH, LRU_BLOCKS, LRU_BLOCK_DIM, LRU_BLOCK_DIM), LRU_BLOCK_DIM ** -0.5),
        'lru_ba': nrm(ks[7], (DEPTH, LRU_BLOCKS, LRU_BLOCK_DIM), 0.01),
        'lru_wx': nrm(ks[8], (DEPTH, LRU_BLOCKS, LRU_BLOCK_DIM, LRU_BLOCK_DIM), LRU_BLOCK_DIM ** -0.5),
        'lru_bx': nrm(ks[10], (DEPTH, LRU_BLOCKS, LRU_BLOCK_DIM), 0.01),
        'lru_lam': jnp.log(lam_a) - jnp.log1p(-lam_a),
        'w_out': nrm(ks[11], (DEPTH, D_MODEL, D_MODEL), D_MODEL ** -0.5 * DN_BETA),
        'ln1_w': 1.0 + nrm(ks[12], (DEPTH, D_MODEL), 0.02),
        'ln1_b': nrm(ks[13], (DEPTH, D_MODEL), 0.01),
        'w_router': nrm(ks[14], (DEPTH, D_MODEL, N_EXPERTS), D_MODEL ** -0.5),
        'b_router': nrm(ks[15], (DEPTH, N_EXPERTS), 0.01),
        'w_gate': nrm(ks[16], (DEPTH, N_EXPERTS, D_MODEL, D_EXPERT), D_MODEL ** -0.5),
        'b_gate': nrm(ks[17], (DEPTH, N_EXPERTS, D_EXPERT), 0.01),
        'w_up': nrm(ks[18], (DEPTH, N_EXPERTS, D_MODEL, D_EXPERT), D_MODEL ** -0.5),
        'b_up': nrm(ks[19], (DEPTH, N_EXPERTS, D_EXPERT), 0.01),
        'w_down': nrm(ks[20], (DEPTH, N_EXPERTS, D_EXPERT, D_MODEL), D_EXPERT ** -0.5 * DN_BETA),
        'b_down': nrm(ks[21], (DEPTH, N_EXPERTS, D_MODEL), 0.01),
        'ln2_w': 1.0 + nrm(ks[22], (DEPTH, D_MODEL), 0.02),
        'ln2_b': nrm(ks[23], (DEPTH, D_MODEL), 0.01),
        'w_ple_proj': nrm(ks[24], (DEPTH, PLE_DIM, D_MODEL), PLE_DIM ** -0.5 * DN_BETA),
        'ple_norm_w': 1.0 + nrm(ks[25], (DEPTH, D_MODEL), 0.02),
        'w_ple_gate': nrm(ks[26], (DEPTH, D_MODEL, D_MODEL), D_MODEL ** -0.5),
    }


def reference(x, p, w_in, ret_gn_w, conv_w, conv_b, lru_wa, lru_ba, lru_wx, lru_bx, lru_lam, w_out,
              ln1_w, ln1_b, w_router, b_router, w_gate, b_gate, w_up, b_up, w_down, b_down,
              ln2_w, ln2_b, w_ple_proj, ple_norm_w, w_ple_gate):
    h = x.astype(jnp.float32)
    for i in range(DEPTH):
        m = hybrid_mixer(h, w_in[i], ret_gn_w[i], conv_w[i], conv_b[i], lru_wa[i], lru_ba[i],
                         lru_wx[i], lru_bx[i], lru_lam[i], w_out[i])
        h = layer_norm(DN_ALPHA * h + m, ln1_w[i], ln1_b[i])
        f = moe(h, w_router[i], b_router[i], w_gate[i], b_gate[i], w_up[i], b_up[i], w_down[i], b_down[i])
        h = layer_norm(DN_ALPHA * h + f, ln2_w[i], ln2_b[i])
        e = rms_norm(jnp.einsum('bsp,pd->bsd', p[i].astype(jnp.float32), w_ple_proj[i].astype(jnp.float32)), ple_norm_w[i])
        gate = jax.nn.sigmoid(jnp.einsum('bsd,de->bse', h, w_ple_gate[i].astype(jnp.float32)))
        h = h + gate * e
    return h.astype(x.dtype)
```

```cpp
#include <hip/hip_runtime.h>
#include <stdint.h>

namespace {
#define LAS __attribute__((address_space(3)))
#define DI __device__ __forceinline__
typedef short bf16x8 __attribute__((ext_vector_type(8)));
typedef short s16x4 __attribute__((ext_vector_type(4)));
typedef float f32x4 __attribute__((ext_vector_type(4)));
typedef float f32x2 __attribute__((ext_vector_type(2)));
typedef __bf16 bf16x4_t __attribute__((ext_vector_type(4)));
typedef __bf16 bf16x2_t __attribute__((ext_vector_type(2)));
typedef unsigned u32x4 __attribute__((ext_vector_type(4)));
typedef unsigned u32x2 __attribute__((ext_vector_type(2)));
typedef unsigned short u16;

constexpr int T = 8192, D = 2048, SEQ = 2048, INC = 6144, RW = 1024, LW = 1024;
constexpr int NE = 32, PLE = 256, CHUNK = 128, NCH = 16, NHEAD = 8;
constexpr float LN_EPS = 1e-5f;
constexpr float DN_ALPHA = 1.189207115002721f;
constexpr int NTHR = 512;
constexpr int LDS_BYTES = 147456;
constexpr int LIST_CAP = 8192;

constexpr size_t WS_CTL   = 0;
constexpr size_t CTL_BYTES = 32768;
constexpr size_t WS_XB    = 65536;
constexpr size_t WS_PB    = WS_XB    + (size_t)T * D * 2;
constexpr size_t WS_ROPE  = WS_PB    + (size_t)T * PLE * 2;
constexpr size_t WS_PROJ  = WS_ROPE  + (size_t)SEQ * 64 * 2 * 4;
constexpr size_t WS_EP    = WS_PROJ  + (size_t)T * INC * 2;
constexpr size_t WS_SSQ   = WS_EP    + (size_t)T * D * 2;
constexpr size_t WS_KV    = WS_SSQ   + (size_t)T * 32 * 4;
constexpr size_t WS_ACUM  = WS_KV    + (size_t)512 * 128 * 128 * 4;
constexpr size_t WS_HLOC  = WS_ACUM  + (size_t)T * LW * 4;
constexpr size_t WS_CA    = WS_HLOC  + (size_t)T * LW * 4;
constexpr size_t WS_CH    = WS_CA    + (size_t)4 * 16 * 1024 * 4;
constexpr size_t WS_MIXED = WS_CH    + (size_t)4 * 16 * 1024 * 4;
constexpr size_t WS_Y1    = WS_MIXED + (size_t)T * D * 2;
constexpr size_t WS_X1B   = WS_Y1    + (size_t)T * D * 4;
constexpr size_t WS_ST1   = WS_X1B   + (size_t)T * D * 2;
constexpr size_t WS_LID   = WS_ST1   + (size_t)T * 2 * 4;
constexpr size_t WS_LGT   = WS_LID   + (size_t)NE * LIST_CAP * 4;
constexpr size_t WS_HID   = WS_LGT   + (size_t)NE * LIST_CAP * 4;
constexpr size_t WS_YBUF  = WS_HID   + (size_t)41984 * 2048 * 2;
constexpr size_t WS_X2B   = WS_YBUF  + (size_t)32768 * 2048 * 2;
constexpr size_t WS_RSE   = WS_X2B   + (size_t)T * D * 2;
constexpr size_t WS_END   = WS_RSE   + (size_t)T * 4;

constexpr int CW_CNT = 4096;

#define XB_TMO      128
#define XB_XCNT(j)  (256  + 64 * (j))
#define XB_XSUB(j)  (1280 + 64 * (j))
#define XB_XGEN(j)  (2304 + 64 * (j))
#define XB_TOP      3328
#define XB_TOPGEN   3392
#define XCD_BAR_WORDS 3456
#define XB_SPIN_CAP (1u << 18)

DI unsigned xb_ld(unsigned* p)              { return __hip_atomic_load(p, __ATOMIC_RELAXED, __HIP_MEMORY_SCOPE_AGENT); }
DI unsigned xb_add(unsigned* p, unsigned v) { return __hip_atomic_fetch_add(p, v, __ATOMIC_RELAXED, __HIP_MEMORY_SCOPE_AGENT); }
DI unsigned xb_xcc_id() { return (unsigned)__builtin_amdgcn_s_getreg((3 << 11) | 20) & 0xFu; }
#define XB_SPIN(cond, bar) do { unsigned _sp = 0; while (cond) { __builtin_amdgcn_s_sleep(1); \
    if ((++_sp & 255u) == 0u) { if (xb_ld(&(bar)[XB_TMO])) break; if (_sp > XB_SPIN_CAP) { atomicAdd(&(bar)[XB_TMO], 1u); break; } } } } while (0)

struct XcdBarrier { unsigned* bar; unsigned x; volatile LAS unsigned* st; };

DI XcdBarrier xcd_barrier_post(unsigned* bar, volatile LAS unsigned* st) {
    XcdBarrier b; b.bar = bar; b.x = xb_xcc_id(); b.st = st;
    if (threadIdx.x == 0) (void)xb_add(&bar[XB_XCNT(b.x)], 1u);
    return b;
}
DI void xcd_barrier_complete(unsigned* bar, unsigned x, unsigned& nloc, unsigned& nx) {
    const unsigned G = gridDim.x * gridDim.y * gridDim.z;
    unsigned sum, cnt, mine, sp = 0u;
    for (;;) {
        sum = 0u; cnt = 0u; mine = 0u;
#pragma unroll
        for (unsigned j = 0; j < 16; ++j) { const unsigned c = xb_ld(&bar[XB_XCNT(j)]); sum += c; cnt += (c > 0u) ? 1u : 0u; mine = (j == x) ? c : mine; }
        if (sum == G) break;
        __builtin_amdgcn_s_sleep(1);
        if ((++sp & 255u) == 0u) { if (xb_ld(&bar[XB_TMO])) break; if (sp > XB_SPIN_CAP) { atomicAdd(&bar[XB_TMO], 1u); break; } }
    }
    nloc = mine > 0u ? mine : 1u; nx = cnt > 0u ? cnt : 1u;
}
DI void xcd_barrier(const XcdBarrier& b) {
    asm volatile("s_waitcnt vmcnt(0)" ::: "memory");
    __syncthreads();
    if (threadIdx.x == 0) {
        unsigned* bar = b.bar;
        __builtin_amdgcn_s_waitcnt(0);
        unsigned nloc = b.st[0], nx = b.st[1];
        if (nloc == 0u) { xcd_barrier_complete(bar, b.x, nloc, nx); b.st[0] = nloc; b.st[1] = nx; }
        const unsigned old = xb_add(&bar[XB_XSUB(b.x)], 1u);
        const unsigned gen = old / nloc;
        if (old + 1u == (gen + 1u) * nloc) {
            __builtin_amdgcn_fence(__ATOMIC_RELEASE, "agent");
            asm volatile("s_waitcnt vmcnt(0)" ::: "memory");
            const unsigned og = xb_add(&bar[XB_TOP], 1u);
            const unsigned tg = og / nx;
            if (og + 1u == (tg + 1u) * nx) xb_add(&bar[XB_TOPGEN], 1u);
            else XB_SPIN(xb_ld(&bar[XB_TOPGEN]) == tg, bar);
            __builtin_amdgcn_fence(__ATOMIC_ACQUIRE, "agent");
            xb_add(&bar[XB_XGEN(b.x)], 1u);
            asm volatile("s_waitcnt vmcnt(0)" ::: "memory");
        } else {
            XB_SPIN(xb_ld(&bar[XB_XGEN(b.x)]) == gen, bar);
            __builtin_amdgcn_fence(__ATOMIC_ACQUIRE, "agent");
            asm volatile("s_waitcnt vmcnt(0)" ::: "memory");
        }
    }
    __syncthreads();
}

DI float bf2f(u16 v) { return __uint_as_float(((unsigned)v) << 16); }
DI float bflo(unsigned w) { return __uint_as_float(w << 16); }
DI float bfhi(unsigned w) { return __uint_as_float(w & 0xffff0000u); }
DI unsigned pack2(float a, float b) { f32x2 v = {a, b}; bf16x2_t r = __builtin_convertvector(v, bf16x2_t); return __builtin_bit_cast(unsigned, r); }
DI u32x2 pack4(f32x4 v) { bf16x4_t r = __builtin_convertvector(v, bf16x4_t); return __builtin_bit_cast(u32x2, r); }
DI float sigmoidf_(float x) { return __builtin_amdgcn_rcpf(1.0f + __expf(-x)); }
DI float gelu_tanh(float x) { const float u = 0.7978845608028654f * (x + 0.044715f * x * x * x); const float e = __expf(2.0f * u); const float th = 1.0f - 2.0f / (e + 1.0f); return 0.5f * x * (1.0f + th); }
#define LP(type, addr) ((LAS type*)(uintptr_t)(addr))
DI s16x4 tr_read(unsigned byte_addr) { return __builtin_amdgcn_ds_read_tr16_b64_v4i16(LP(s16x4, byte_addr)); }
DI s16x4 tr_read_na(LAS s16x4* __restrict__ p) { return __builtin_amdgcn_ds_read_tr16_b64_v4i16(p); }
DI bf16x8 cat8(s16x4 lo, s16x4 hi) { return __builtin_shufflevector(lo, hi, 0, 1, 2, 3, 4, 5, 6, 7); }
#define MFMA16(a, b, c) __builtin_amdgcn_mfma_f32_16x16x32_bf16((a), (b), (c), 0, 0, 0)
DI int trrow(int k) { return k ^ ((k >> 1) & 4); }

DI int lane_id() { int l; asm volatile("v_mbcnt_lo_u32_b32 %0, -1, 0\n\tv_mbcnt_hi_u32_b32 %0, -1, %0" : "=v"(l)); return l; }

struct Params {
    const float* in[27];
    float* out;
    unsigned char* ws;
};
typedef const __attribute__((address_space(4))) Params* KPtr;
DI KPtr kargs() { KPtr p = (KPtr)__builtin_amdgcn_kernarg_segment_ptr(); asm volatile("" : "+s"(p)); return p; }

constexpr int G_BSTRIDE = 544, G_BBUF = 64 * G_BSTRIDE, G_B0 = 0, G_B1 = G_BBUF, G_AREG = 0;
#define OPAQUE_LDS(p) asm volatile("" : "+v"(p))
typedef int i32x4 __attribute__((ext_vector_type(4)));
DI __amdgpu_buffer_rsrc_t mk_rsrc(const void* p) { return __builtin_amdgcn_make_buffer_rsrc((void*)p, 0, 0x7FFFFFF0, 0x00020000); }
DI u32x4 bload16(__amdgpu_buffer_rsrc_t r, unsigned voff, unsigned soff) { return __builtin_bit_cast(u32x4, __builtin_amdgcn_raw_buffer_load_b128(r, (int)voff, (int)soff, 0)); }

template <bool GU, class U, class S, int MF = 8>
DI void gemm_stream(LAS unsigned char* lds, const int wid, int nt, const int ldb, const S& sched) {
    constexpr int ABUF = MF * 4096, G_A0 = 0, G_A1 = ABUF, G_BREG = 2 * ABUF, NG = 2 * MF;
    asm volatile("" : "+s"(nt));
    const int lane = lane_id(), wr = wid >> 2, wc = wid & 3, fr = lane & 15, fq = lane >> 4;
    U cur;
    if (!sched.get(0, cur)) return;
    __amdgpu_buffer_rsrc_t rsB0, rsB1, rsA; unsigned voa0, voa1, voa2, voa3, voa4 = 0;
#define G_SETUP_B(u) do { rsB0 = mk_rsrc((u).b0); rsB1 = mk_rsrc((u).b1); } while (0)
#define G_SETUP_A(u) do { \
        const int _l = lane_id(), sb_ = _l * 16, swz = sb_ ^ (((sb_ >> 9) & 1) << 5); \
        const int R0 = (wid >> 1) * 16 + (swz >> 6), C0 = (wid & 1) * 32 + ((swz & 63) >> 1); \
        rsA = mk_rsrc((u).al.base()); \
        voa0 = (u).al.rowoff(R0) + C0 * 2; voa1 = (u).al.rowoff(R0 + 64) + C0 * 2; voa2 = (u).al.rowoff(R0 + 128) + C0 * 2; voa3 = (u).al.rowoff(R0 + 192) + C0 * 2; \
        if (MF == 9) voa4 = (u).al.rowoff(256 + ((wid >> 1) & 1) * 16 + (swz >> 6)) + C0 * 2;        \
        } while (0)
#define G_SETUP(u) do { G_SETUP_B(u); G_SETUP_A(u); } while (0)
    G_SETUP(cur);
    const int hl = lane >> 5, sc = (lane & 31) * 4;
    const unsigned vob = (unsigned)((2 * wid + hl) * ldb + sc) * 4u;
    const unsigned kstepB = (unsigned)ldb * 64u;
    const int pos0 = (GU ? (sc >> 5) * 64 : (sc & ~31)) + ((sc >> 2) & 1) * 16 + ((sc >> 3) & 3) * 4;
    LAS unsigned char* b_wr = lds + G_BREG + (((2 * wid + hl) ^ (wid & 4)) * G_BSTRIDE) + pos0 * 2; OPAQUE_LDS(b_wr);
    constexpr int SLAB1 = GU ? 64 : 256;
    LAS unsigned char* a_rd = lds + G_AREG + wr * (MF * 2048) + ((fr * 64 + fq * 16) ^ (((fr >> 3) & 1) << 5)); OPAQUE_LDS(a_rd);
    const int q = (lane & 15) >> 2, p = lane & 3;
    LAS unsigned char* b_rd0 = lds + G_BREG + fq * (8 * G_BSTRIDE) + (((fq & 1) * 4 + q) * G_BSTRIDE) + wc * 128 + p * 8; OPAQUE_LDS(b_rd0);
    LAS unsigned char* b_rd1 = lds + G_BREG + fq * (8 * G_BSTRIDE) + ((((fq & 1) ^ 1) * 4 + q) * G_BSTRIDE) + wc * 128 + p * 8; OPAQUE_LDS(b_rd1);

    f32x4 acc[MF][4];
    u32x4 sb[8];
    LAS unsigned char* a_dma = lds + G_AREG + wid * 1024;

#define G_DMA_A(kt, AO) do { G_DMA1(kt, AO, 0); G_DMA1(kt, AO, 1); G_DMA1(kt, AO, 2); G_DMA1(kt, AO, 3); if (MF == 9) G_DMA5(kt, AO); } while (0)
#define G_ISSUE_B(kt) do { const unsigned _sb = (unsigned)(kt) * 4u * kstepB; \
        _Pragma("unroll") for (int _i = 0; _i < 8; ++_i) sb[_i] = bload16(_i < 4 ? rsB0 : rsB1, vob, _sb + (_i & 3) * kstepB); } while (0)
#define G_WRITE_B(BO) do { \
        _Pragma("unroll") for (int _i = 0; _i < 8; ++_i) *(LAS u32x2*)(b_wr + (BO) + (_i & 3) * (16 * G_BSTRIDE) + (_i >> 2) * SLAB1) = pack4(__builtin_bit_cast(f32x4, sb[_i])); } while (0)
#define G_DMA1(kt, AO, pc) __builtin_amdgcn_raw_ptr_buffer_load_lds(rsA, (LAS void*)(a_dma + (AO) + (pc) * 8192), 16, (int)((pc) == 0 ? voa0 : (pc) == 1 ? voa1 : (pc) == 2 ? voa2 : voa3), (int)((unsigned)(kt) * 128u), 0, 0)
#define G_DMA5(kt, AO) __builtin_amdgcn_raw_ptr_buffer_load_lds(rsA, (LAS void*)(lds + G_AREG + (AO) + 32768 + (wid & 3) * 1024), 16, (int)voa4, (int)((unsigned)(kt) * 128u), 0, 0)
#define G_WR1(BO, i) (*(LAS u32x2*)(b_wr + (BO) + ((i) & 3) * (16 * G_BSTRIDE) + ((i) >> 2) * SLAB1) = pack4(__builtin_bit_cast(f32x4, sb[i])))
#define G_LD1(kt, i) (sb[i] = bload16(((i) < 4) ? rsB0 : rsB1, vob, (unsigned)(kt) * 4u * kstepB + (unsigned)((i) & 3) * kstepB))
#define G_RD_A(AO, ks, m) (*(const LAS bf16x8*)(a_rd + (AO) + (m) * 2048 + (ks) * 1024))
#define G_TR(BO, ks, n) cat8(tr_read_na((LAS s16x4*)(b_rd0 + (BO) + (ks) * (32 * G_BSTRIDE) + (n) * 32)), \
                             tr_read_na((LAS s16x4*)(b_rd1 + (BO) + (ks) * (32 * G_BSTRIDE) + (n) * 32)))
#define G_TILE(AR, BR, DO_MEM, BW, AW, kA, HAS_B, kB, HOOK) do { \
        bf16x8 Bf[4], Af[3]; \
        _Pragma("unroll") for (int n = 0; n < 4; ++n) Bf[n] = G_TR(BR, 0, n); \
        Af[0] = G_RD_A(AR, 0, 0); Af[1] = G_RD_A(AR, 0, 1); \
        _Pragma("unroll") for (int g = 0; g < NG; ++g) { const int m = g % MF; \
            if (g < NG - 2) Af[(g + 2) % 3] = G_RD_A(AR, (g + 2) / MF, (g + 2) % MF); \
            if (DO_MEM && g == 0) { G_DMA1(kA, AW, 0); G_DMA1(kA, AW, 1); G_DMA1(kA, AW, 2); G_DMA1(kA, AW, 3); if (MF == 9) G_DMA5(kA, AW); HOOK; } \
            _Pragma("unroll") for (int n = 0; n < 4; ++n) { acc[m][n] = MFMA16(Bf[n], Af[g % 3], acc[m][n]); \
                if (g == MF - 1) Bf[n] = G_TR(BR, 1, n); }            \
            if (DO_MEM && (g & 1) && g < 16) { G_WR1(BW, g >> 1); __builtin_amdgcn_sched_barrier(0); if (HAS_B) G_LD1(kB, g >> 1); } \
            __builtin_amdgcn_sched_barrier(0); } \
    } while (0)
#define G_ENDTILE(VM) do { asm volatile("s_waitcnt vmcnt(" #VM ")" ::: "memory"); \
        asm volatile("s_waitcnt lgkmcnt(0)" ::: "memory"); __builtin_amdgcn_s_barrier(); asm volatile("" ::: "memory"); } while (0)

    __builtin_amdgcn_s_barrier();
    G_DMA_A(0, G_A0); G_ISSUE_B(0); G_WRITE_B(G_B0);
    __builtin_amdgcn_sched_barrier(0);
    G_ISSUE_B(1);
    __builtin_amdgcn_sched_barrier(0);
    G_ENDTILE(8);
    for (int ui = 0;; ++ui) {
#pragma unroll
        for (int m = 0; m < MF; ++m)
#pragma unroll
            for (int n = 0; n < 4; ++n) acc[m][n] = (f32x4){0.f, 0.f, 0.f, 0.f};
        for (int t = 0; t < nt - 2; t += 2) {
            G_TILE(G_A0, G_B0, true, G_B1, G_A1, t + 1, true, t + 2, (void)0);
            G_ENDTILE(8);
            G_TILE(G_A1, G_B1, true, G_B0, G_A0, t + 2, true, t + 3, (void)0);
            G_ENDTILE(8);
        }
        U nxt = cur;
        const bool has_next = sched.get(ui + 1, nxt);
        G_SETUP_B(nxt);
        G_TILE(G_A0, G_B0, true, G_B1, G_A1, nt - 1, true, 0, G_SETUP_A(nxt));
        G_ENDTILE(8);
        G_TILE(G_A1, G_B1, true, G_B0, G_A0, 0, true, 1, (void)0);
        G_ENDTILE(8);
        { const int l2 = lane_id(); cur.ep(acc, wr, wc, l2 & 15, l2 >> 4); }
        if (!has_next) break;
        cur = nxt;
    }
    asm volatile("s_waitcnt vmcnt(0)" ::: "memory");
#undef G_SETUP_A
#undef G_SETUP_B
#undef G_SETUP
#undef G_DMA_A
#undef G_ISSUE_B
#undef G_WRITE_B
#undef G_DMA1
#undef G_DMA5
#undef G_WR1
#undef G_LD1
#undef G_RD_A
#undef G_TR
#undef G_TILE
#undef G_ENDTILE
}

struct ARows { const u16* b; int lda; DI const void* base() const { return b; } DI unsigned rowoff(int r) const { return (unsigned)(r * lda) * 2u; } };
struct AGather { const u16* x; const int* ids; int m0, cnt; DI const void* base() const { return x; }
    DI unsigned rowoff(int r) const { int i = m0 + r; i = i < cnt ? i : cnt - 1;
        const unsigned v = (unsigned)__builtin_amdgcn_raw_buffer_load_b32(__builtin_amdgcn_make_buffer_rsrc((void*)ids, 0, 0x7FFFFFF0, 0x00020000), i * 4, 0, 0);
        return (v >> 2) * (unsigned)(D * 2); } };

struct Ctx {
    LAS unsigned char* lds; unsigned char* ws; unsigned* ctl; int wid, bid, G;
};

DI void p0_prologue(const Ctx& c) {
    const KPtr kp = kargs();
    const int tid = c.wid * 64 + lane_id();
    const size_t gt = (size_t)c.bid * NTHR + tid, gs = (size_t)c.G * NTHR;
    { const f32x4* src = (const f32x4*)kp->in[0]; u32x4* dst = (u32x4*)(c.ws + WS_XB);
      for (size_t i = gt; i < (size_t)T * D / 8; i += gs) { const f32x4 a = src[2 * i], b = src[2 * i + 1]; const u32x2 lo = pack4(a), hi = pack4(b); dst[i] = (u32x4){lo.x, lo.y, hi.x, hi.y}; } }
    { const f32x4* src = (const f32x4*)kp->in[1]; u32x4* dst = (u32x4*)(c.ws + WS_PB);
      for (size_t i = gt; i < (size_t)T * PLE / 8; i += gs) { const f32x4 a = src[2 * i], b = src[2 * i + 1]; const u32x2 lo = pack4(a), hi = pack4(b); dst[i] = (u32x4){lo.x, lo.y, hi.x, hi.y}; } }
    { f32x2* rope = (f32x2*)(c.ws + WS_ROPE);
      for (size_t i = gt; i < (size_t)SEQ * 64; i += gs) { const int pos = (int)(i >> 6), k = (int)(i & 63);
        const float inv = exp2f(-(float)k * (13.287712379549449f / 64.0f));
        const float ang = (float)pos * inv;
        double rv = (double)ang * 0.15915494309189535; rv -= floor(rv);
        const float f = (float)rv;
        rope[i] = (f32x2){__builtin_amdgcn_cosf(f), __builtin_amdgcn_sinf(f)}; } }
}

struct EpiProj { u16* out; int row0, col0;
    DI void operator()(const f32x4 (&acc)[8][4], int wr, int wc, int fr, int fq) const {
#pragma unroll
        for (int m = 0; m < 8; ++m) { u16* rp = out + (size_t)(row0 + wr * 128 + m * 16 + fr) * INC + col0 + wc * 64 + 8 * fq;
#pragma unroll
            for (int h = 0; h < 2; ++h) { const u32x2 lo = pack4(acc[m][2 * h]), hi = pack4(acc[m][2 * h + 1]); *(u32x4*)(rp + h * 32) = (u32x4){lo.x, lo.y, hi.x, hi.y}; } }
    } };
struct EpiPle { u16* out; float* ssq; int row0, ntile;
    DI void operator()(const f32x4 (&acc)[8][4], int wr, int wc, int fr, int fq) const {
#pragma unroll
        for (int m = 0; m < 8; ++m) { const int row = row0 + wr * 128 + m * 16 + fr; u16* rp = out + (size_t)row * D + ntile * 256 + wc * 64 + 8 * fq; float s = 0.f;
#pragma unroll
            for (int n = 0; n < 4; ++n) { const f32x4 v = acc[m][n]; s += (v[0] * v[0] + v[1] * v[1]) + (v[2] * v[2] + v[3] * v[3]); }
#pragma unroll
            for (int h = 0; h < 2; ++h) { const u32x2 lo = pack4(acc[m][2 * h]), hi = pack4(acc[m][2 * h + 1]); *(u32x4*)(rp + h * 32) = (u32x4){lo.x, lo.y, hi.x, hi.y}; }
            s += __shfl_xor(s, 16); s += __shfl_xor(s, 32);
            if (fq == 0) ssq[(size_t)row * 32 + ntile * 4 + wc] = s; }
    } };
struct EpiY1 { const u16* x; u16* y; int row0, col0;
    DI void operator()(const f32x4 (&acc)[8][4], int wr, int wc, int fr, int fq) const {
#pragma unroll
        for (int m = 0; m < 8; ++m) { const size_t off = (size_t)(row0 + wr * 128 + m * 16 + fr) * D + col0 + wc * 64 + 8 * fq;
#pragma unroll
            for (int h = 0; h < 2; ++h) { const u32x4 xr = *(const u32x4*)(x + off + h * 32);
                const f32x4 x0 = {bflo(xr.x), bfhi(xr.x), bflo(xr.y), bfhi(xr.y)}, x1 = {bflo(xr.z), bfhi(xr.z), bflo(xr.w), bfhi(xr.w)};
                const u32x2 lo = pack4(x0 * DN_ALPHA + acc[m][2 * h]), hi = pack4(x1 * DN_ALPHA + acc[m][2 * h + 1]); *(u32x4*)(y + off + h * 32) = (u32x4){lo.x, lo.y, hi.x, hi.y}; } }
    } };
struct EpiHid { u16* hid; const float* bg; const float* bu; int row0, hc0;
    template <int MF> DI void operator()(const f32x4 (&acc)[MF][4], int wr, int wc, int fr, int fq) const {
        const int hc = hc0 + wc * 32 + 8 * fq;
        f32x4 bgv[2], buv[2];
#pragma unroll
        for (int n = 0; n < 2; ++n) { bgv[n] = *(const f32x4*)(bg + hc + 4 * n); buv[n] = *(const f32x4*)(bu + hc + 4 * n); }
#pragma unroll
        for (int m = 0; m < MF; ++m) { u16* rp = hid + (size_t)(row0 + wr * (16 * MF) + m * 16 + fr) * D + hc; u32x2 w[2];
#pragma unroll
            for (int n = 0; n < 2; ++n) { f32x4 g = acc[m][n] + bgv[n], u = acc[m][n + 2] + buv[n], h;
#pragma unroll
                for (int j = 0; j < 4; ++j) { const float gt = fminf(g[j], 7.0f); const float up = fminf(fmaxf(u[j], -7.0f), 7.0f); h[j] = (up + 1.0f) * gt * sigmoidf_(1.702f * gt); }
                w[n] = pack4(h); }
            *(u32x4*)rp = (u32x4){w[0].x, w[0].y, w[1].x, w[1].y}; }
    } };
struct EpiDown { u16* ybuf; const float* bd; const int* ids; const float* gts; int m0, cnt, col0;
    template <int MF> DI void operator()(const f32x4 (&acc)[MF][4], int wr, int wc, int fr, int fq) const {
        f32x4 bv[4];
#pragma unroll
        for (int n = 0; n < 4; ++n) bv[n] = *(const f32x4*)(bd + col0 + wc * 64 + 32 * (n >> 1) + 8 * fq + 4 * (n & 1));
#pragma unroll
        for (int m = 0; m < MF; ++m) { const int i = m0 + wr * (16 * MF) + m * 16 + fr;
            if (i < cnt) { const int id = ids[i]; const float g = gts[i]; u16* rp = ybuf + (size_t)id * D + col0 + wc * 64 + 8 * fq;
#pragma unroll
                for (int h = 0; h < 2; ++h) { const u32x2 lo = pack4((acc[m][2 * h] + bv[2 * h]) * g), hi = pack4((acc[m][2 * h + 1] + bv[2 * h + 1]) * g);
                    *(u32x4*)(rp + h * 32) = (u32x4){lo.x, lo.y, hi.x, hi.y}; } } }
    } };
struct EpiOut { float* out; const u16* x2b; const u16* ep; const float* rse; const float* pnw; int row0, col0;
    DI void operator()(const f32x4 (&acc)[8][4], int wr, int wc, int fr, int fq) const {
        f32x4 wv[4];
#pragma unroll
        for (int n = 0; n < 4; ++n) wv[n] = *(const f32x4*)(pnw + col0 + wc * 64 + 32 * (n >> 1) + 8 * fq + 4 * (n & 1));
#pragma unroll
        for (int m = 0; m < 8; ++m) { const int row = row0 + wr * 128 + m * 16 + fr; const float rs = rse[row]; const size_t off = (size_t)row * D + col0 + wc * 64 + 8 * fq;
#pragma unroll
            for (int h = 0; h < 2; ++h) { const u32x4 xr = *(const u32x4*)(x2b + off + h * 32), er = *(const u32x4*)(ep + off + h * 32);
                const unsigned xw[4] = {xr.x, xr.y, xr.z, xr.w}, ew[4] = {er.x, er.y, er.z, er.w};
#pragma unroll
                for (int q = 0; q < 2; ++q) { const f32x4 a = acc[m][2 * h + q]; const f32x4 w4 = wv[2 * h + q]; f32x4 o;
                    o[0] = bflo(xw[2 * q]) + sigmoidf_(a[0]) * bflo(ew[2 * q]) * rs * w4[0]; o[1] = bfhi(xw[2 * q]) + sigmoidf_(a[1]) * bfhi(ew[2 * q]) * rs * w4[1];
                    o[2] = bflo(xw[2 * q + 1]) + sigmoidf_(a[2]) * bflo(ew[2 * q + 1]) * rs * w4[2]; o[3] = bfhi(xw[2 * q + 1]) + sigmoidf_(a[3]) * bfhi(ew[2 * q + 1]) * rs * w4[3];
                    *(f32x4*)(out + off + h * 32 + 4 * q) = o; } } }
    } };

DI bool deal_tiles(int bid, int G, int nM, int nN, int i, int& pm, int& pn) {
    const int x = bid & 7, r = bid >> 3, W = G >> 3;
    const int mper = nM >> 3;
    const int q = i * W + r;
    if (q >= mper * nN) return false;
    pm = x * mper + (q % mper); pn = q / mper; return true;
}

template <class EP> struct UnitD { ARows al; const float* b0; const float* b1; EP ep; DI int rows() const { return 256; } };
struct SchedProj { int bid, G; const u16* xb; const float* w; u16* proj;
    DI bool get(int i, UnitD<EpiProj>& u) const { int pm, pn; if (!deal_tiles(bid, G, T / 256, INC / 256, i, pm, pn)) return false;
        u.al = ARows{xb + (size_t)pm * 256 * D, D}; u.b0 = w + pn * 256; u.b1 = u.b0 + 128; u.ep = EpiProj{proj, pm * 256, pn * 256}; return true; } };
struct SchedPle { int bid, G; const u16* pb; const float* w; u16* epo; float* ssq;
    DI bool get(int i, UnitD<EpiPle>& u) const { int pm, pn; if (!deal_tiles(bid, G, T / 256, D / 256, i, pm, pn)) return false;
        u.al = ARows{pb + (size_t)pm * 256 * PLE, PLE}; u.b0 = w + pn * 256; u.b1 = u.b0 + 128; u.ep = EpiPle{epo, ssq, pm * 256, pn}; return true; } };
struct SchedY1 { int bid, G; const u16* mx; const float* w; const u16* x; u16* y;
    DI bool get(int i, UnitD<EpiY1>& u) const { int pm, pn; if (!deal_tiles(bid, G, T / 256, D / 256, i, pm, pn)) return false;
        u.al = ARows{mx + (size_t)pm * 256 * D, D}; u.b0 = w + pn * 256; u.b1 = u.b0 + 128; u.ep = EpiY1{x, y, pm * 256, pn * 256}; return true; } };
struct SchedOut { int bid, G; const u16* xb; const float* w; float* out; const u16* epi; const float* rse; const float* pnw;
    DI bool get(int i, UnitD<EpiOut>& u) const { int pm, pn; if (!deal_tiles(bid, G, T / 256, D / 256, i, pm, pn)) return false;
        u.al = ARows{xb + (size_t)pm * 256 * D, D}; u.b0 = w + pn * 256; u.b1 = u.b0 + 128; u.ep = EpiOut{out, xb, epi, rse, pnw, pm * 256, pn * 256}; return true; } };

DI void p1_gemm(const Ctx& c) {
    const KPtr kp = kargs();
    { const SchedProj S{c.bid, c.G, (const u16*)(c.ws + WS_XB), kp->in[2], (u16*)(c.ws + WS_PROJ)};
      gemm_stream<false, UnitD<EpiProj>>(c.lds, c.wid, D / 64, INC, S); }
    { const SchedPle S{c.bid, c.G, (const u16*)(c.ws + WS_PB), kp->in[24], (u16*)(c.ws + WS_EP), (float*)(c.ws + WS_SSQ)};
      gemm_stream<false, UnitD<EpiPle>>(c.lds, c.wid, PLE / 64, D, S); }
}
DI void p3_gemm(const Ctx& c) {
    const KPtr kp = kargs();
    const SchedY1 S{c.bid, c.G, (const u16*)(c.ws + WS_MIXED), kp->in[11], (const u16*)(c.ws + WS_XB), (u16*)(c.ws + WS_Y1)};
    gemm_stream<false, UnitD<EpiY1>>(c.lds, c.wid, D / 64, D, S);
}
DI void p8_gemm(const Ctx& c) {
    const KPtr kp = kargs();
    const SchedOut S{c.bid, c.G, (const u16*)(c.ws + WS_X2B), kp->in[26], kp->out, (const u16*)(c.ws + WS_EP), (const float*)(c.ws + WS_RSE), kp->in[25]};
    gemm_stream<false, UnitD<EpiOut>>(c.lds, c.wid, D / 64, D, S);
}

constexpr int MOE_MF = 9, MOE_BM = 32 * MOE_MF;
constexpr int MS_OFF = 143424;
template <bool ALL>
DI void moe_build_sched(const Ctx& c) {
    LAS int* S = (LAS int*)(c.lds + MS_OFF);
    __syncthreads();
    if (c.wid == 0) {
        const int lane = lane_id(), x = c.bid & 7;
        const int myc = (lane < NE) ? (int)c.ctl[CW_CNT + 64 * lane] : 0;
        int load[8] = {0, 0, 0, 0, 0, 0, 0, 0}; int hb = 0, nown = 0;
#pragma unroll
        for (int e = 0; e < NE; ++e) { const int cn = __builtin_amdgcn_readlane(myc, e), mc = (cn + MOE_BM - 1) / MOE_BM;
            int best = 0, bl = load[0];
#pragma unroll
            for (int j = 1; j < 8; ++j) { const bool lt = load[j] < bl; bl = lt ? load[j] : bl; best = lt ? j : best; }
#pragma unroll
            for (int j = 0; j < 8; ++j) load[j] += (j == best) ? mc : 0;
            if ((ALL || best == x) && mc > 0) { if (lane == 0) { S[8 + 4 * nown] = e; S[9 + 4 * nown] = mc; S[10 + 4 * nown] = cn; S[11 + 4 * nown] = hb; } ++nown; }
            hb += mc * MOE_BM; }
        if (lane == 0) S[0] = nown;
    }
    __syncthreads();
}
DI bool moe_find(const Ctx& c, int qi, int NT, int& e, int& nt, int& mt, int& cn, int& hb) {
    LAS int* S = (LAS int*)(c.lds + MS_OFF);
    const int nown = __builtin_amdgcn_readfirstlane(S[0]); int accu = 0;
    for (int k = 0; k < nown; ++k) { const int mc = __builtin_amdgcn_readfirstlane(S[9 + 4 * k]);
        if (qi < accu + NT * mc) { const int loc = qi - accu; nt = loc / mc; mt = loc - nt * mc;
            e = __builtin_amdgcn_readfirstlane(S[8 + 4 * k]); cn = __builtin_amdgcn_readfirstlane(S[10 + 4 * k]); hb = __builtin_amdgcn_readfirstlane(S[11 + 4 * k]); return true; }
        accu += NT * mc; }
    return false;
}
struct UnitUp { AGather al; const float* b0; const float* b1; EpiHid ep; int nrows; DI int rows() const { return nrows; } };
struct SchedUp { const Ctx& c; int r, W; const u16* x1b; const int* lid; const float* wg; const float* wu; const float* bg; const float* bu; u16* hid;
    DI bool get(int i, UnitUp& u) const { int e, nt, mt, cn, hb; if (!moe_find(c, r + i * W, 2, e, nt, mt, cn, hb)) return false; nt = (c.bid & 7) + 8 * nt;
        u.al = AGather{x1b, lid + e * LIST_CAP, mt * MOE_BM, cn}; u.b0 = wg + (size_t)e * D * D + nt * 128; u.b1 = wu + (size_t)e * D * D + nt * 128;
        u.ep = EpiHid{hid, bg + e * D, bu + e * D, hb + mt * MOE_BM, nt * 128}; u.nrows = cn - mt * MOE_BM; return true; } };
struct UnitDown { ARows al; const float* b0; const float* b1; EpiDown ep; int nrows; DI int rows() const { return nrows; } };
struct SchedDown { const Ctx& c; int r, W; const u16* hid; const int* lid; const float* lgt; const float* wd; const float* bd; u16* ybuf;
    DI bool get(int i, UnitDown& u) const { int e, nt, mt, cn, hb; if (!moe_find(c, r + i * W, 8, e, nt, mt, cn, hb)) return false;
        u.al = ARows{hid + (size_t)(hb + mt * MOE_BM) * D, D}; u.b0 = wd + (size_t)e * D * D + nt * 256; u.b1 = u.b0 + 128;
        u.ep = EpiDown{ybuf, bd + e * D, lid + e * LIST_CAP, lgt + e * LIST_CAP, mt * MOE_BM, cn, nt * 256}; u.nrows = cn - mt * MOE_BM; return true; } };
DI void p5_moe_up(const Ctx& c) {
    const KPtr kp = kargs();
    moe_build_sched<true>(c);
    const SchedUp S{c, c.bid >> 3, c.G >> 3, (const u16*)(c.ws + WS_X1B), (const int*)(c.ws + WS_LID), kp->in[16], kp->in[18], kp->in[17], kp->in[19], (u16*)(c.ws + WS_HID)};
    gemm_stream<true, UnitUp, SchedUp, MOE_MF>(c.lds, c.wid, D / 64, D, S);
}
DI void p6_moe_down(const Ctx& c) {
    const KPtr kp = kargs();
    moe_build_sched<false>(c);
    const SchedDown S{c, c.bid >> 3, c.G >> 3, (const u16*)(c.ws + WS_HID), (const int*)(c.ws + WS_LID), (const float*)(c.ws + WS_LGT), kp->in[20], kp->in[21], (u16*)(c.ws + WS_YBUF)};
    gemm_stream<false, UnitDown, SchedDown, MOE_MF>(c.lds, c.wid, D / 64, D, S);
}

DI float head_log_gamma(int h) { return log1pf(-exp2f(-5.0f - (float)h)); }

template <bool TRIMG>
DI void stage_rope(const Ctx& c, unsigned dst, int stride, int t0, int col0, int pos0, float scale, float lg, bool kdec) {
    const u16* proj = (const u16*)(c.ws + WS_PROJ); const f32x2* rope = (const f32x2*)(c.ws + WS_ROPE); const int tid = c.wid * 64 + lane_id();
#pragma unroll
    for (int it = 0; it < 2; ++it) { const int item = tid + it * NTHR, j = item >> 3, pc = item & 7, dd = pc * 8;
        const u16* rp = proj + (size_t)(t0 + j) * INC + col0 + dd;
        const u32x4 a = *(const u32x4*)rp, b = *(const u32x4*)(rp + 64);
        const f32x4* cs = (const f32x4*)(rope + (size_t)(pos0 + j) * 64 + dd);
        const f32x4 c0 = cs[0], c1 = cs[1], c2 = cs[2], c3 = cs[3];
        const float sc = kdec ? scale * __expf((float)(127 - j) * lg) : scale;
        float x1[8] = {bflo(a.x), bfhi(a.x), bflo(a.y), bfhi(a.y), bflo(a.z), bfhi(a.z), bflo(a.w), bfhi(a.w)};
        float x2[8] = {bflo(b.x), bfhi(b.x), bflo(b.y), bfhi(b.y), bflo(b.z), bfhi(b.z), bflo(b.w), bfhi(b.w)};
        const float cc[8] = {c0[0], c0[2], c1[0], c1[2], c2[0], c2[2], c3[0], c3[2]};
        const float ss[8] = {c0[1], c0[3], c1[1], c1[3], c2[1], c2[3], c3[1], c3[3]};
        float o1[8], o2[8];
#pragma unroll
        for (int k = 0; k < 8; ++k) { o1[k] = (x1[k] * cc[k] - x2[k] * ss[k]) * sc; o2[k] = (x1[k] * ss[k] + x2[k] * cc[k]) * sc; }
        const int row = TRIMG ? trrow(j) : j;
        *LP(u32x4, dst + row * stride + dd * 2) = (u32x4){pack2(o1[0], o1[1]), pack2(o1[2], o1[3]), pack2(o1[4], o1[5]), pack2(o1[6], o1[7])};
        *LP(u32x4, dst + row * stride + (64 + dd) * 2) = (u32x4){pack2(o2[0], o2[1]), pack2(o2[2], o2[3]), pack2(o2[4], o2[5]), pack2(o2[6], o2[7])}; }
}
template <bool TRIMG>
DI void stage_plain(const Ctx& c, unsigned dst, int stride, int t0, int col0) {
    const u16* proj = (const u16*)(c.ws + WS_PROJ); const int tid = c.wid * 64 + lane_id();
#pragma unroll
    for (int it = 0; it < 4; ++it) { const int item = tid + it * NTHR, j = item >> 4, ch = item & 15;
        const u32x4 a = *(const u32x4*)(proj + (size_t)(t0 + j) * INC + col0 + ch * 8);
        const int row = TRIMG ? trrow(j) : j;
        *LP(u32x4, dst + row * stride + ch * 16) = a; }
}
DI bf16x8 tr_frag(unsigned img, int stride, int k0, int n0, int lane) {
    const int fq = lane >> 4, q = (lane & 15) >> 2, p = lane & 3;
    const int kb = k0 + 8 * fq, par = (kb >> 3) & 1;
    const unsigned a0 = img + (kb + ((par * 4) + q)) * stride + n0 * 2 + p * 8;
    const unsigned a1 = img + (kb + (((par ^ 1) * 4) + q)) * stride + n0 * 2 + p * 8;
    return cat8(tr_read(a0), tr_read(a1));
}
DI bf16x8 row_frag(unsigned img, int stride, int r0, int k0, int lane) {
    return *LP(const bf16x8, img + (r0 + (lane & 15)) * stride + (k0 + 8 * (lane >> 4)) * 2);
}

constexpr int RS = 272, TS = 288;
constexpr int IMG_R = 128 * RS, IMG_T = 128 * TS;

DI void ret_kv_unit(const Ctx& c, int u) {
    const int h = u & 7, n = (u >> 3) & 15, b = u >> 7;
    const int t0 = b * SEQ + n * CHUNK; const float lg = head_log_gamma(h);
    const unsigned base = (unsigned)(size_t)c.lds, Kimg = base, Vimg = base + IMG_T;
    __syncthreads();
    stage_rope<true>(c, Kimg, TS, t0, RW + h * 128, n * CHUNK, 0.08838834764831845f, lg, true);
    stage_plain<true>(c, Vimg, TS, t0, 2 * RW + h * 128);
    __syncthreads();
    f32x4 acc[8];
#pragma unroll
    for (int i = 0; i < 8; ++i) acc[i] = (f32x4){0.f, 0.f, 0.f, 0.f};
    const int d0 = c.wid * 16, lane = lane_id();
#pragma unroll
    for (int ks = 0; ks < 4; ++ks) { const bf16x8 kf = tr_frag(Kimg, TS, ks * 32, d0, lane);
#pragma unroll
        for (int ef = 0; ef < 8; ++ef) acc[ef] = MFMA16(tr_frag(Vimg, TS, ks * 32, ef * 16, lane), kf, acc[ef]); }
    u16* kv = (u16*)(c.ws + WS_KV) + (size_t)((b * NHEAD + h) * NCH + n) * 16384;
    const int d = d0 + (lane & 15), fq = lane >> 4;
#pragma unroll
    for (int ef = 0; ef < 8; ++ef) *(u32x2*)(kv + d * 128 + ef * 16 + 4 * fq) = pack4(acc[ef]);
}

DI void ret_out_unit(const Ctx& c, int u) {
    const KPtr kp = kargs();
    const int h = u & 7, n = (u >> 3) & 15, b = u >> 7;
    const int t0 = b * SEQ + n * CHUNK; const float lg = head_log_gamma(h);
    const unsigned base = (unsigned)(size_t)c.lds, Qimg = base, Kimg = base + IMG_R, Vimg = base + 2 * IMG_R, Simg = base + 2 * IMG_R + IMG_T;
    const u16* proj = (const u16*)(c.ws + WS_PROJ);
    __syncthreads();
    stage_rope<false>(c, Qimg, RS, t0, h * 128, n * CHUNK, 1.0f, lg, false);
    stage_rope<false>(c, Kimg, RS, t0, RW + h * 128, n * CHUNK, 0.08838834764831845f, lg, false);
    stage_plain<true>(c, Vimg, TS, t0, 2 * RW + h * 128);
    {
        const float cd = __expf(128.0f * lg);
        const u16* kv = (const u16*)(c.ws + WS_KV) + (size_t)((b * NHEAD + h) * NCH) * 16384; const int tid = c.wid * 64 + lane_id();
        f32x4 s[8];
#pragma unroll
        for (int i = 0; i < 8; ++i) s[i] = (f32x4){0.f, 0.f, 0.f, 0.f};
#pragma unroll 4
        for (int m = 0; m < n; ++m) { const u32x2* src = (const u32x2*)(kv + (size_t)m * 16384);
#pragma unroll
            for (int i = 0; i < 8; ++i) { const u32x2 v = src[tid + i * NTHR]; s[i] = s[i] * cd + (f32x4){bflo(v.x), bfhi(v.x), bflo(v.y), bfhi(v.y)}; } }
#pragma unroll
        for (int i = 0; i < 8; ++i) { const int idx = tid + i * NTHR, dd = idx >> 5, e4 = (idx & 31) * 4;
            *LP(u32x2, Simg + trrow(dd) * TS + e4 * 2) = pack4(s[i]); }
    }
    __syncthreads();
    const int w = c.wid, lane = lane_id(), fq = lane >> 4, il = 16 * w + (lane & 15);
    bf16x8 qf[4];
#pragma unroll
    for (int ks = 0; ks < 4; ++ks) qf[ks] = row_frag(Qimg, RS, 16 * w, ks * 32, lane);
    f32x4 acc[8];
#pragma unroll
    for (int i = 0; i < 8; ++i) acc[i] = (f32x4){0.f, 0.f, 0.f, 0.f};
#pragma unroll
    for (int ks = 0; ks < 4; ++ks)
#pragma unroll
        for (int ef = 0; ef < 8; ++ef) acc[ef] = MFMA16(tr_frag(Simg, TS, ks * 32, ef * 16, lane), qf[ks], acc[ef]);
    { const float qd = __expf((float)(il + 1) * lg);
#pragma unroll
      for (int ef = 0; ef < 8; ++ef) acc[ef] *= qd; }
    f32x4 sc[8];
#pragma unroll
    for (int jf = 0; jf < 8; ++jf) { sc[jf] = (f32x4){0.f, 0.f, 0.f, 0.f};
        if (jf <= w) {
#pragma unroll
            for (int ks = 0; ks < 4; ++ks) sc[jf] = MFMA16(row_frag(Kimg, RS, jf * 16, ks * 32, lane), qf[ks], sc[jf]);
#pragma unroll
            for (int r = 0; r < 4; ++r) { const int j = jf * 16 + 4 * fq + r; sc[jf][r] = (il >= j) ? sc[jf][r] * __expf((float)(il - j) * lg) : 0.f; }
        } }
    __syncthreads();
    const unsigned Pimg = Kimg;
#pragma unroll
    for (int jf = 0; jf < 8; ++jf) *LP(u32x2, Pimg + il * RS + (jf * 16 + 4 * fq) * 2) = pack4(sc[jf]);
    __syncthreads();
#pragma unroll
    for (int ks = 0; ks < 4; ++ks) if (ks <= (w >> 1)) { const bf16x8 pf = row_frag(Pimg, RS, 16 * w, ks * 32, lane);
#pragma unroll
        for (int ef = 0; ef < 8; ++ef) acc[ef] = MFMA16(tr_frag(Vimg, TS, ks * 32, ef * 16, lane), pf, acc[ef]); }
    float s = 0.f;
#pragma unroll
    for (int ef = 0; ef < 8; ++ef) s += (acc[ef][0] + acc[ef][1]) + (acc[ef][2] + acc[ef][3]);
    s += __shfl_xor(s, 16); s += __shfl_xor(s, 32);
    const float mean = s * (1.0f / 128.0f); float qv = 0.f;
#pragma unroll
    for (int ef = 0; ef < 8; ++ef) { const f32x4 dlt = acc[ef] - mean; qv += (dlt[0] * dlt[0] + dlt[1] * dlt[1]) + (dlt[2] * dlt[2] + dlt[3] * dlt[3]); }
    qv += __shfl_xor(qv, 16); qv += __shfl_xor(qv, 32);
    const float rstd = rsqrtf(qv * (1.0f / 128.0f) + LN_EPS);
    const float* gnw = kp->in[3] + h * 128; u16* mixed = (u16*)(c.ws + WS_MIXED);
    const size_t trow = (size_t)(t0 + il);
#pragma unroll
    for (int ef = 0; ef < 8; ++ef) { const int e = ef * 16 + 4 * fq; const f32x4 gw = *(const f32x4*)(gnw + e);
        const u32x2 gb = *(const u32x2*)(proj + trow * INC + 3 * RW + h * 128 + e);
        const float g[4] = {bflo(gb.x), bfhi(gb.x), bflo(gb.y), bfhi(gb.y)}; f32x4 o;
#pragma unroll
        for (int r = 0; r < 4; ++r) o[r] = (acc[ef][r] - mean) * rstd * gw[r] * (g[r] * sigmoidf_(g[r]));
        *(u32x2*)(mixed + trow * D + h * 128 + e) = pack4(o); }
}

constexpr int LAS_STR = 132;
DI void lru_local_unit(const Ctx& c, int u) {
    const KPtr kp = kargs();
    const int blk = u & 7, n = (u >> 3) & 15, b = u >> 7;
    const int t0 = b * SEQ + n * CHUNK, cb = blk * 128;
    const unsigned base = (unsigned)(size_t)c.lds, Aimg = base, Waimg = base + IMG_R, Wximg = base + IMG_R + IMG_T;
    const u16* proj = (const u16*)(c.ws + WS_PROJ);
    const float* conv_w = kp->in[4]; const float* conv_b = kp->in[5];
    __syncthreads();
    {
        const float* wa = kp->in[6] + (size_t)blk * 16384; const float* wx = kp->in[8] + (size_t)blk * 16384;
        const int tid = c.wid * 64 + lane_id();
#pragma unroll
        for (int it = 0; it < 8; ++it) { const int item = tid + it * NTHR, i = item >> 5, jc = item & 31;
            *LP(u32x2, Waimg + trrow(i) * TS + jc * 8) = pack4(*(const f32x4*)(wa + i * 128 + jc * 4));
            *LP(u32x2, Wximg + trrow(i) * TS + jc * 8) = pack4(*(const f32x4*)(wx + i * 128 + jc * 4)); }
    }
    {
        const int tid = c.wid * 64 + lane_id(); const int tr = tid >> 4, cc = tid & 15, ch = cb + cc * 8;
        float xin[7][8];
#pragma unroll
        for (int rr = 0; rr < 7; ++rr) { const int tl = 4 * tr - 3 + rr;
            if (n == 0 && tl < 0) {
#pragma unroll
                for (int k = 0; k < 8; ++k) xin[rr][k] = 0.f;
            } else { const u32x4 v = *(const u32x4*)(proj + (size_t)(t0 + tl) * INC + 4 * RW + ch);
                xin[rr][0] = bflo(v.x); xin[rr][1] = bfhi(v.x); xin[rr][2] = bflo(v.y); xin[rr][3] = bfhi(v.y); xin[rr][4] = bflo(v.z); xin[rr][5] = bfhi(v.z); xin[rr][6] = bflo(v.w); xin[rr][7] = bfhi(v.w); } }
        float wv[4][8], bv[8];
#pragma unroll
        for (int j = 0; j < 4; ++j) { const f32x4 w0 = *(const f32x4*)(conv_w + j * LW + ch), w1 = *(const f32x4*)(conv_w + j * LW + ch + 4);
            wv[j][0] = w0[0]; wv[j][1] = w0[1]; wv[j][2] = w0[2]; wv[j][3] = w0[3]; wv[j][4] = w1[0]; wv[j][5] = w1[1]; wv[j][6] = w1[2]; wv[j][7] = w1[3]; }
        { const f32x4 b0 = *(const f32x4*)(conv_b + ch), b1 = *(const f32x4*)(conv_b + ch + 4); bv[0] = b0[0]; bv[1] = b0[1]; bv[2] = b0[2]; bv[3] = b0[3]; bv[4] = b1[0]; bv[5] = b1[1]; bv[6] = b1[2]; bv[7] = b1[3]; }
#pragma unroll
        for (int r = 0; r < 4; ++r) { float o[8];
#pragma unroll
            for (int k = 0; k < 8; ++k) o[k] = bv[k] + wv[0][k] * xin[r][k] + wv[1][k] * xin[r + 1][k] + wv[2][k] * xin[r + 2][k] + wv[3][k] * xin[r + 3][k];
            *LP(u32x4, Aimg + (4 * tr + r) * RS + cc * 16) = (u32x4){pack2(o[0], o[1]), pack2(o[2], o[3]), pack2(o[4], o[5]), pack2(o[6], o[7])}; }
    }
    __syncthreads();
    const int wr = c.wid >> 2, wc = c.wid & 3; int lane = lane_id(); int fr = lane & 15, fq = lane >> 4;
    f32x4 aR[4][2], aG[4][2];
#pragma unroll
    for (int m = 0; m < 4; ++m)
#pragma unroll
        for (int nn = 0; nn < 2; ++nn) { aR[m][nn] = (f32x4){0.f, 0.f, 0.f, 0.f}; aG[m][nn] = (f32x4){0.f, 0.f, 0.f, 0.f}; }
#pragma unroll
    for (int ks = 0; ks < 4; ++ks) { bf16x8 xf[4];
#pragma unroll
        for (int m = 0; m < 4; ++m) xf[m] = row_frag(Aimg, RS, wr * 64 + m * 16, ks * 32, lane);
#pragma unroll
        for (int nn = 0; nn < 2; ++nn) { const bf16x8 fa = tr_frag(Waimg, TS, ks * 32, wc * 32 + nn * 16, lane), fx = tr_frag(Wximg, TS, ks * 32, wc * 32 + nn * 16, lane);
#pragma unroll
            for (int m = 0; m < 4; ++m) { aR[m][nn] = MFMA16(fa, xf[m], aR[m][nn]); aG[m][nn] = MFMA16(fx, xf[m], aG[m][nn]); } } }
    __syncthreads();
    lane = lane_id(); fr = lane & 15; fq = lane >> 4;
    LAS float* LA = (LAS float*)c.lds; LAS float* LB = LA + 128 * LAS_STR;
    const float* ba = kp->in[7] + cb; const float* bx_ = kp->in[9] + cb; const float* lam = kp->in[10] + cb;
#pragma unroll
    for (int nn = 0; nn < 2; ++nn) { const int cl = wc * 32 + nn * 16 + 4 * fq;
        const f32x4 bav = *(const f32x4*)(ba + cl), bxv = *(const f32x4*)(bx_ + cl), lmv = *(const f32x4*)(lam + cl), cbv = *(const f32x4*)(conv_b + cb + cl);
        f32x4 cw[4], lsg;
#pragma unroll
        for (int j = 0; j < 4; ++j) cw[j] = *(const f32x4*)(conv_w + j * LW + cb + cl);
#pragma unroll
        for (int r = 0; r < 4; ++r) lsg[r] = -log1pf(__expf(-lmv[r]));
#pragma unroll
        for (int m = 0; m < 4; ++m) { const int tl = wr * 64 + m * 16 + fr;
            f32x4 xc = cbv;
#pragma unroll
            for (int j = 0; j < 4; ++j) { const int tt = tl - 3 + j;
                if (!(n == 0 && tt < 0)) { const u32x2 v = *(const u32x2*)(proj + (size_t)(t0 + tt) * INC + 4 * RW + cb + cl);
                    xc[0] += cw[j][0] * bflo(v.x); xc[1] += cw[j][1] * bfhi(v.x); xc[2] += cw[j][2] * bflo(v.y); xc[3] += cw[j][3] * bfhi(v.y); } }
            f32x4 av, bvv;
#pragma unroll
            for (int r = 0; r < 4; ++r) { const float rg = sigmoidf_(aR[m][nn][r] + bav[r]), gi = sigmoidf_(aG[m][nn][r] + bxv[r]);
                const float la = 8.0f * rg * lsg[r]; av[r] = __expf(la); bvv[r] = sqrtf(-expm1f(2.0f * la)) * (gi * xc[r]); }
            *(LAS f32x4*)(LA + tl * LAS_STR + cl) = av; *(LAS f32x4*)(LB + tl * LAS_STR + cl) = bvv;
            __builtin_amdgcn_sched_barrier(0); } }
    __syncthreads();
    LAS float* SEGA = LB + 128 * LAS_STR;
    LAS float* SEGH = SEGA + 512;
    const int tid2 = c.wid * 64 + lane_id(); const int ch = tid2 & 127, sg = tid2 >> 7;
    { float A = 1.f, H = 0.f;
      for (int t = sg * 32; t < sg * 32 + 32; ++t) { const float a = LA[t * LAS_STR + ch], bb = LB[t * LAS_STR + ch]; H = a * H + bb; A *= a; LA[t * LAS_STR + ch] = A; LB[t * LAS_STR + ch] = H; }
      SEGA[sg * 128 + ch] = A; SEGH[sg * 128 + ch] = H; }
    __syncthreads();
    { float Ain = 1.f, Hin = 0.f;
      for (int s2 = 0; s2 < sg; ++s2) { const float a = SEGA[s2 * 128 + ch], hh = SEGH[s2 * 128 + ch]; Hin = a * Hin + hh; Ain *= a; }
      u16* acum = (u16*)(c.ws + WS_ACUM); u16* hloc = (u16*)(c.ws + WS_HLOC);
      float A = 1.f, H = 0.f;
      for (int t = sg * 32; t < sg * 32 + 32; ++t) { A = LA[t * LAS_STR + ch] * Ain; H = LB[t * LAS_STR + ch] + LA[t * LAS_STR + ch] * Hin;
          acum[(size_t)(t0 + t) * LW + cb + ch] = (u16)(pack2(A, 0.f) & 0xffffu); hloc[(size_t)(t0 + t) * LW + cb + ch] = (u16)(pack2(H, 0.f) & 0xffffu); }
      if (sg == 3) { ((float*)(c.ws + WS_CA))[(b * NCH + n) * LW + cb + ch] = A; ((float*)(c.ws + WS_CH))[(b * NCH + n) * LW + cb + ch] = H; } }
}

DI void lru_fin_unit(const Ctx& c, int u) {
    const int blk = u & 7, n = (u >> 3) & 15, b = u >> 7;
    const int t0 = b * SEQ + n * CHUNK, cb = blk * 128;
    LAS float* hin = (LAS float*)c.lds; const int tid = c.wid * 64 + lane_id();
    __syncthreads();
    if (tid < 128) { const float* ca = (const float*)(c.ws + WS_CA) + (size_t)b * NCH * LW + cb + tid; const float* chh = (const float*)(c.ws + WS_CH) + (size_t)b * NCH * LW + cb + tid;
        float hcar = 0.f; for (int m = 0; m < n; ++m) hcar = ca[m * LW] * hcar + chh[m * LW]; hin[tid] = hcar; }
    __syncthreads();
    const u16* acum = (const u16*)(c.ws + WS_ACUM); const u16* hloc = (const u16*)(c.ws + WS_HLOC); const u16* proj = (const u16*)(c.ws + WS_PROJ); u16* mixed = (u16*)(c.ws + WS_MIXED);
#pragma unroll
    for (int it = 0; it < 8; ++it) { const int item = tid + it * NTHR, t = item >> 5, c4 = (item & 31) * 4;
        const size_t o = (size_t)(t0 + t) * LW + cb + c4;
        const u32x2 ar = *(const u32x2*)(acum + o), hr = *(const u32x2*)(hloc + o);
        const f32x4 a = {bflo(ar.x), bfhi(ar.x), bflo(ar.y), bfhi(ar.y)}, hl = {bflo(hr.x), bfhi(hr.x), bflo(hr.y), bfhi(hr.y)}, hi4 = *(const LAS f32x4*)(hin + c4);
        const u32x2 yb = *(const u32x2*)(proj + (size_t)(t0 + t) * INC + 5 * RW + cb + c4);
        const float yg[4] = {bflo(yb.x), bfhi(yb.x), bflo(yb.y), bfhi(yb.y)}; f32x4 ov;
#pragma unroll
        for (int r = 0; r < 4; ++r) ov[r] = gelu_tanh(yg[r]) * (hl[r] + a[r] * hi4[r]);
        *(u32x2*)(mixed + (size_t)(t0 + t) * D + RW + cb + c4) = pack4(ov); }
}

constexpr int XSTR = 4112;
DI void p4_ln_router(const Ctx& c) {
    const KPtr kp = kargs();
    const int lane = lane_id(), w = c.wid, fq = lane >> 4, fr = lane & 15, tid = c.wid * 64 + lane;
    const unsigned base = (unsigned)(size_t)c.lds, Xhi = base, Xlo = base + 16 * XSTR;
    LAS float* red = (LAS float*)c.lds;
    LAS float* logit = (LAS float*)(c.lds + 135168);
    LAS int* sel_e = (LAS int*)(c.lds + 135168 + 4096);
    LAS float* sel_g = (LAS float*)(c.lds + 135168 + 4096 + 512);
    LAS int* sel_p = (LAS int*)(c.lds + 135168 + 4096 + 1024);
    LAS unsigned* lcnt = (LAS unsigned*)(c.lds + 135168 + 4096 + 1536);
    LAS unsigned* gbase = lcnt + 32;
    const u16* y1 = (const u16*)(c.ws + WS_Y1); const float* lw = kp->in[12]; const float* lb = kp->in[13];
    const float* wr_ = kp->in[14]; const float* br_ = kp->in[15];
    u16* x1b = (u16*)(c.ws + WS_X1B); float* st1 = (float*)(c.ws + WS_ST1);
    for (int tb = c.bid; tb < T / 32; tb += c.G) {
    __syncthreads();
    if (tid < 32) lcnt[tid] = 0u;
    const int tokbase = tb * 32;
    for (int pass = 0; pass < 2; ++pass) {
        __syncthreads();
        for (int tt = 0; tt < 2; ++tt) { const int tl = 2 * w + tt, tok = tokbase + pass * 16 + tl;
            const u32x2* src = (const u32x2*)(y1 + (size_t)tok * D); f32x4 v[8]; float s = 0.f;
#pragma unroll
            for (int i = 0; i < 8; ++i) { const u32x2 yv = src[i * 64 + lane]; v[i] = (f32x4){bflo(yv.x), bfhi(yv.x), bflo(yv.y), bfhi(yv.y)}; s += (v[i][0] + v[i][1]) + (v[i][2] + v[i][3]); }
#pragma unroll
            for (int o = 32; o >= 1; o >>= 1) s += __shfl_xor(s, o);
            const float mean = s * (1.0f / D); float qv = 0.f;
#pragma unroll
            for (int i = 0; i < 8; ++i) { const f32x4 dl = v[i] - mean; qv += (dl[0] * dl[0] + dl[1] * dl[1]) + (dl[2] * dl[2] + dl[3] * dl[3]); }
#pragma unroll
            for (int o = 32; o >= 1; o >>= 1) qv += __shfl_xor(qv, o);
            const float rstd = rsqrtf(qv * (1.0f / D) + LN_EPS);
            if (lane == 0) { st1[2 * tok] = mean; st1[2 * tok + 1] = rstd; }
#pragma unroll
            for (int i = 0; i < 8; ++i) { const int d = (i * 64 + lane) * 4; const f32x4 g = *(const f32x4*)(lw + d), bb = *(const f32x4*)(lb + d);
                const f32x4 xv = (v[i] - mean) * rstd * g + bb;
                const u32x2 hi = pack4(xv); const f32x4 rsd = {xv[0] - bflo(hi.x), xv[1] - bfhi(hi.x), xv[2] - bflo(hi.y), xv[3] - bfhi(hi.y)};
                *(u32x2*)(x1b + (size_t)tok * D + d) = hi;
                *LP(u32x2, Xhi + tl * XSTR + d * 2) = hi; *LP(u32x2, Xlo + tl * XSTR + d * 2) = pack4(rsd); } }
        __syncthreads();
        f32x4 acc[2] = {(f32x4){0.f, 0.f, 0.f, 0.f}, (f32x4){0.f, 0.f, 0.f, 0.f}};
#pragma unroll 2
        for (int ks = 0; ks < 8; ++ks) { const int k0 = 256 * w + 32 * ks + 8 * fq;
            const bf16x8 xh = *LP(const bf16x8, Xhi + fr * XSTR + k0 * 2), xl = *LP(const bf16x8, Xlo + fr * XSTR + k0 * 2);
#pragma unroll
            for (int nf = 0; nf < 2; ++nf) {
                float v[8]; const int e = nf * 16 + fr;
#pragma unroll
                for (int j = 0; j < 8; ++j) v[j] = wr_[(size_t)(k0 + j) * NE + e];
                unsigned hw[4], lwv[4];
#pragma unroll
                for (int j = 0; j < 4; ++j) { hw[j] = pack2(v[2 * j], v[2 * j + 1]); lwv[j] = pack2(v[2 * j] - bflo(hw[j]), v[2 * j + 1] - bfhi(hw[j])); }
                const bf16x8 wh = __builtin_bit_cast(bf16x8, (u32x4){hw[0], hw[1], hw[2], hw[3]}), wl = __builtin_bit_cast(bf16x8, (u32x4){lwv[0], lwv[1], lwv[2], lwv[3]});
                acc[nf] = MFMA16(wh, xh, acc[nf]); acc[nf] = MFMA16(wh, xl, acc[nf]); acc[nf] = MFMA16(wl, xh, acc[nf]); } }
        __syncthreads();
#pragma unroll
        for (int nf = 0; nf < 2; ++nf)
#pragma unroll
            for (int r = 0; r < 4; ++r) red[(w * 16 + fr) * 32 + nf * 16 + 4 * fq + r] = acc[nf][r];
        __syncthreads();
        { const int tl = tid >> 5, e = tid & 31; float s = br_[e];
#pragma unroll
          for (int ww = 0; ww < 8; ++ww) s += red[(ww * 16 + tl) * 32 + e];
          logit[(pass * 16 + tl) * 32 + e] = s; }
    }
    __syncthreads();
    if (tid < 32) { float l[32];
#pragma unroll
        for (int e = 0; e < 32; ++e) l[e] = logit[tid * 32 + e];
        float tv[4]; int te[4];
#pragma unroll
        for (int k = 0; k < 4; ++k) { float best = -3.0e38f; int bi = 0;
#pragma unroll
            for (int e = 0; e < 32; ++e) { const bool tk = l[e] > best; best = tk ? l[e] : best; bi = tk ? e : bi; }
            tv[k] = best; te[k] = bi;
#pragma unroll
            for (int e = 0; e < 32; ++e) l[e] = (e == bi) ? -3.0e38f : l[e]; }
        float ex[4], sum = 0.f;
#pragma unroll
        for (int k = 0; k < 4; ++k) { ex[k] = __expf(tv[k] - tv[0]); sum += ex[k]; }
        const float inv = 1.0f / sum;
#pragma unroll
        for (int k = 0; k < 4; ++k) { sel_e[tid * 4 + k] = te[k]; sel_g[tid * 4 + k] = ex[k] * inv; sel_p[tid * 4 + k] = (int)atomicAdd((unsigned*)&lcnt[te[k]], 1u); } }
    __syncthreads();
    { const int t2 = c.wid * 64 + lane_id(); if (t2 < 32) gbase[t2] = lcnt[t2] ? atomicAdd(c.ctl + CW_CNT + 64 * t2, lcnt[t2]) : 0u; }
    __syncthreads();
    { const int t3 = c.wid * 64 + lane_id(); if (t3 < 128) { const int e = sel_e[t3]; const int slot = (int)gbase[e] + sel_p[t3];
        int* lid = (int*)(c.ws + WS_LID); float* lgt = (float*)(c.ws + WS_LGT);
        lid[e * LIST_CAP + slot] = (tokbase + (t3 >> 2)) * 4 + (t3 & 3); lgt[e * LIST_CAP + slot] = sel_g[t3]; } }
    }
}

DI void p7_ln2(const Ctx& c) {
    const KPtr kp = kargs();
    const int lane = lane_id();
    const u16* y1 = (const u16*)(c.ws + WS_Y1); const float* st1 = (const float*)(c.ws + WS_ST1); const u16* yb = (const u16*)(c.ws + WS_YBUF);
    const float* l1w = kp->in[12]; const float* l1b = kp->in[13]; const float* l2w = kp->in[22]; const float* l2b = kp->in[23];
    u16* x2b = (u16*)(c.ws + WS_X2B); const float* ssq = (const float*)(c.ws + WS_SSQ); float* rse = (float*)(c.ws + WS_RSE);
    for (int tb = c.bid; tb < T / 32; tb += c.G)
    for (int tt = 0; tt < 4; ++tt) { const int tok = tb * 32 + c.wid * 4 + tt;
        const float mean1 = st1[2 * tok], rstd1 = st1[2 * tok + 1];
        f32x4 z[8]; float s = 0.f;
#pragma unroll
        for (int i = 0; i < 8; ++i) { const int d = (i * 64 + lane) * 4; const u32x2 yr = *(const u32x2*)(y1 + (size_t)tok * D + d); const f32x4 yv = {bflo(yr.x), bfhi(yr.x), bflo(yr.y), bfhi(yr.y)}, g = *(const f32x4*)(l1w + d), bb = *(const f32x4*)(l1b + d);
            f32x4 a = ((yv - mean1) * rstd1 * g + bb) * DN_ALPHA;
#pragma unroll
            for (int k = 0; k < 4; ++k) { const u32x2 v = *(const u32x2*)(yb + ((size_t)tok * 4 + k) * D + d); a[0] += bflo(v.x); a[1] += bfhi(v.x); a[2] += bflo(v.y); a[3] += bfhi(v.y); }
            z[i] = a; s += (a[0] + a[1]) + (a[2] + a[3]); }
#pragma unroll
        for (int o = 32; o >= 1; o >>= 1) s += __shfl_xor(s, o);
        const float mean = s * (1.0f / D); float qv = 0.f;
#pragma unroll
        for (int i = 0; i < 8; ++i) { const f32x4 dl = z[i] - mean; qv += (dl[0] * dl[0] + dl[1] * dl[1]) + (dl[2] * dl[2] + dl[3] * dl[3]); }
#pragma unroll
        for (int o = 32; o >= 1; o >>= 1) qv += __shfl_xor(qv, o);
        const float rstd = rsqrtf(qv * (1.0f / D) + LN_EPS);
#pragma unroll
        for (int i = 0; i < 8; ++i) { const int d = (i * 64 + lane) * 4; const f32x4 g = *(const f32x4*)(l2w + d), bb = *(const f32x4*)(l2b + d);
            const f32x4 xv = (z[i] - mean) * rstd * g + bb;
            *(u32x2*)(x2b + (size_t)tok * D + d) = pack4(xv); }
        float q2 = (lane < 32) ? ssq[(size_t)tok * 32 + lane] : 0.f;
#pragma unroll
        for (int o = 32; o >= 1; o >>= 1) q2 += __shfl_xor(q2, o);
        if (lane == 0) rse[tok] = rsqrtf(q2 * (1.0f / D) + LN_EPS); }
}

__global__ void __launch_bounds__(NTHR, 2) hybrid_fwd(Params P) {
    extern __shared__ __attribute__((aligned(16))) unsigned char lds_raw[];
    Ctx c; c.lds = (LAS unsigned char*)lds_raw; c.ws = P.ws; c.ctl = (unsigned*)(P.ws + WS_CTL);
    c.wid = __builtin_amdgcn_readfirstlane(threadIdx.x >> 6); c.bid = blockIdx.x; c.G = gridDim.x;
    volatile LAS unsigned* xbw = (volatile LAS unsigned*)(c.lds + LDS_BYTES - 16);
    if (threadIdx.x == 0) { xbw[0] = 0u; xbw[1] = 0u; xbw[2] = 0u; xbw[3] = 0u; }
    __syncthreads();
    const XcdBarrier bar = xcd_barrier_post(c.ctl, xbw);

#ifndef PHMASK
#define PHMASK 0xFFFF
#endif
#define PH(k) if ((PHMASK >> (k)) & 1)
#ifndef DBLMASK
#define DBLMASK 0
#endif
#define DBL(k) if ((DBLMASK >> (k)) & 1)
    PH(0) p0_prologue(c);
    DBL(0) p0_prologue(c);
    xcd_barrier(bar);
    PH(1) p1_gemm(c);
    DBL(1) p1_gemm(c);
    xcd_barrier(bar);
    PH(2) for (int u = c.bid; u < 512; u += c.G) ret_kv_unit(c, u);
    PH(3) for (int u = c.bid; u < 512; u += c.G) lru_local_unit(c, u);
    DBL(2) for (int u = c.bid; u < 512; u += c.G) ret_kv_unit(c, u);
    DBL(3) for (int u = c.bid; u < 512; u += c.G) lru_local_unit(c, u);
    xcd_barrier(bar);
    PH(4) for (int u = c.bid; u < 512; u += c.G) ret_out_unit(c, u);
    PH(5) for (int u = c.bid; u < 512; u += c.G) lru_fin_unit(c, u);
    DBL(4) for (int u = c.bid; u < 512; u += c.G) ret_out_unit(c, u);
    DBL(5) for (int u = c.bid; u < 512; u += c.G) lru_fin_unit(c, u);
    xcd_barrier(bar);
    PH(6) p3_gemm(c);
    DBL(6) p3_gemm(c);
    xcd_barrier(bar);
    PH(7) p4_ln_router(c);
    xcd_barrier(bar);
    PH(8) p5_moe_up(c);
    DBL(8) p5_moe_up(c);
    xcd_barrier(bar);
    PH(9) p6_moe_down(c);
    DBL(9) p6_moe_down(c);
    xcd_barrier(bar);
    PH(10) p7_ln2(c);
    DBL(10) p7_ln2(c);
    xcd_barrier(bar);
    PH(11) p8_gemm(c);
}
}

extern "C" void kernel_launch(void* const* d_in, const int* in_sizes, int n_in, void* d_out, int out_size, void* d_ws, size_t ws_size, hipStream_t stream) {
    static int grid = 0;
    if (grid == 0) {
        int dev = 0, cus = 0, per_cu = 0;
        if (n_in != 27 || ws_size < WS_END) { grid = -1; return; }
        if (hipGetDevice(&dev) != hipSuccess || hipDeviceGetAttribute(&cus, hipDeviceAttributeMultiprocessorCount, dev) != hipSuccess) { grid = -1; return; }
        if (hipFuncSetAttribute((const void*)hybrid_fwd, hipFuncAttributeMaxDynamicSharedMemorySize, LDS_BYTES) != hipSuccess) { grid = -1; return; }
        (void)hipOccupancyMaxActiveBlocksPerMultiprocessor(&per_cu, (const void*)hybrid_fwd, NTHR, LDS_BYTES);
        (void)hipGetLastError();
        if (per_cu < 1) { grid = -1; return; }
        grid = (cus / 8) * 8;
        if (grid > 256) grid = 256;
    }
    if (grid <= 0) return;
    (void)in_sizes; (void)out_size;
    (void)hipMemsetAsync((char*)d_ws + WS_CTL, 0, CTL_BYTES, stream);
    Params p{};
    for (int i = 0; i < 27; ++i) p.in[i] = (const float*)d_in[i];
    p.out = (float*)d_out; p.ws = (unsigned char*)d_ws;
    hipLaunchKernelGGL(hybrid_fwd, dim3(grid), dim3(NTHR), LDS_BYTES, stream, p);
}
```

```cpp
#include <hip/hip_runtime.h>
#include <stdint.h>

namespace {
#define LAS __attribute__((address_space(3)))
#define DI __device__ __forceinline__
typedef short bf16x8 __attribute__((ext_vector_type(8)));
typedef short s16x4 __attribute__((ext_vector_type(4)));
typedef float f32x4 __attribute__((ext_vector_type(4)));
typedef float f32x2 __attribute__((ext_vector_type(2)));
typedef __bf16 bf16x4_t __attribute__((ext_vector_type(4)));
typedef __bf16 bf16x2_t __attribute__((ext_vector_type(2)));
typedef unsigned u32x4 __attribute__((ext_vector_type(4)));
typedef unsigned u32x2 __attribute__((ext_vector_type(2)));
typedef unsigned short u16;

constexpr int T = 8192, D = 2048, SEQ = 2048, INC = 6144, RW = 1024, LW = 1024;
constexpr int NE = 32, PLE = 256, CHUNK = 128, NCH = 16, NHEAD = 8;
constexpr float LN_EPS = 1e-5f;
constexpr float DN_ALPHA = 1.189207115002721f;
constexpr int NTHR = 512;
constexpr int LDS_BYTES = 147456;
constexpr int LIST_CAP = 8192;

constexpr size_t WS_CTL   = 0;
constexpr size_t CTL_BYTES = 32768;
constexpr size_t WS_XB    = 65536;
constexpr size_t WS_PB    = WS_XB    + (size_t)T * D * 2;
constexpr size_t WS_ROPE  = WS_PB    + (size_t)T * PLE * 2;
constexpr size_t WS_PROJ  = WS_ROPE  + (size_t)SEQ * 64 * 2 * 4;
constexpr size_t WS_EP    = WS_PROJ  + (size_t)T * INC * 2;
constexpr size_t WS_SSQ   = WS_EP    + (size_t)T * D * 2;
constexpr size_t WS_KV    = WS_SSQ   + (size_t)T * 32 * 4;
constexpr size_t WS_ACUM  = WS_KV    + (size_t)512 * 128 * 128 * 4;
constexpr size_t WS_HLOC  = WS_ACUM  + (size_t)T * LW * 4;
constexpr size_t WS_CA    = WS_HLOC  + (size_t)T * LW * 4;
constexpr size_t WS_CH    = WS_CA    + (size_t)4 * 16 * 1024 * 4;
constexpr size_t WS_MIXED = WS_CH    + (size_t)4 * 16 * 1024 * 4;
constexpr size_t WS_Y1    = WS_MIXED + (size_t)T * D * 2;
constexpr size_t WS_X1B   = WS_Y1    + (size_t)T * D * 4;
constexpr size_t WS_ST1   = WS_X1B   + (size_t)T * D * 2;
constexpr size_t WS_LID   = WS_ST1   + (size_t)T * 2 * 4;
constexpr size_t WS_LGT   = WS_LID   + (size_t)NE * LIST_CAP * 4;
constexpr size_t WS_HID   = WS_LGT   + (size_t)NE * LIST_CAP * 4;
constexpr size_t WS_YBUF  = WS_HID   + (size_t)41984 * 2048 * 2;
constexpr size_t WS_X2B   = WS_YBUF  + (size_t)32768 * 2048 * 2;
constexpr size_t WS_RSE   = WS_X2B   + (size_t)T * D * 2;
constexpr size_t WS_END   = WS_RSE   + (size_t)T * 4;

constexpr int CW_CNT = 4096;

#define XB_TMO      128
#define XB_XCNT(j)  (256  + 64 * (j))
#define XB_XSUB(j)  (1280 + 64 * (j))
#define XB_XGEN(j)  (2304 + 64 * (j))
#define XB_TOP      3328
#define XB_TOPGEN   3392
#define XCD_BAR_WORDS 3456
#define XB_SPIN_CAP (1u << 18)

DI unsigned xb_ld(unsigned* p)              { return __hip_atomic_load(p, __ATOMIC_RELAXED, __HIP_MEMORY_SCOPE_AGENT); }
DI unsigned xb_add(unsigned* p, unsigned v) { return __hip_atomic_fetch_add(p, v, __ATOMIC_RELAXED, __HIP_MEMORY_SCOPE_AGENT); }
DI unsigned xb_xcc_id() { return (unsigned)__builtin_amdgcn_s_getreg((3 << 11) | 20) & 0xFu; }
#define XB_SPIN(cond, bar) do { unsigned _sp = 0; while (cond) { __builtin_amdgcn_s_sleep(1); \
    if ((++_sp & 255u) == 0u) { if (xb_ld(&(bar)[XB_TMO])) break; if (_sp > XB_SPIN_CAP) { atomicAdd(&(bar)[XB_TMO], 1u); break; } } } } while (0)

struct XcdBarrier { unsigned* bar; unsigned x; volatile LAS unsigned* st; };

DI XcdBarrier xcd_barrier_post(unsigned* bar, volatile LAS unsigned* st) {
    XcdBarrier b; b.bar = bar; b.x = xb_xcc_id(); b.st = st;
    if (threadIdx.x == 0) (void)xb_add(&bar[XB_XCNT(b.x)], 1u);
    return b;
}
DI void xcd_barrier_complete(unsigned* bar, unsigned x, unsigned& nloc, unsigned& nx) {
    const unsigned G = gridDim.x * gridDim.y * gridDim.z;
    unsigned sum, cnt, mine, sp = 0u;
    for (;;) {
        sum = 0u; cnt = 0u; mine = 0u;
#pragma unroll
        for (unsigned j = 0; j < 16; ++j) { const unsigned c = xb_ld(&bar[XB_XCNT(j)]); sum += c; cnt += (c > 0u) ? 1u : 0u; mine = (j == x) ? c : mine; }
        if (sum == G) break;
        __builtin_amdgcn_s_sleep(1);
        if ((++sp & 255u) == 0u) { if (xb_ld(&bar[XB_TMO])) break; if (sp > XB_SPIN_CAP) { atomicAdd(&bar[XB_TMO], 1u); break; } }
    }
    nloc = mine > 0u ? mine : 1u; nx = cnt > 0u ? cnt : 1u;
}
DI void xcd_barrier(const XcdBarrier& b) {
    asm volatile("s_waitcnt vmcnt(0)" ::: "memory");
    __syncthreads();
    if (threadIdx.x == 0) {
        unsigned* bar = b.bar;
        __builtin_amdgcn_s_waitcnt(0);
        unsigned nloc = b.st[0], nx = b.st[1];
        if (nloc == 0u) { xcd_barrier_complete(bar, b.x, nloc, nx); b.st[0] = nloc; b.st[1] = nx; }
        const unsigned old = xb_add(&bar[XB_XSUB(b.x)], 1u);
        const unsigned gen = old / nloc;
        if (old + 1u == (gen + 1u) * nloc) {
            __builtin_amdgcn_fence(__ATOMIC_RELEASE, "agent");
            asm volatile("s_waitcnt vmcnt(0)" ::: "memory");
            const unsigned og = xb_add(&bar[XB_TOP], 1u);
            const unsigned tg = og / nx;
            if (og + 1u == (tg + 1u) * nx) xb_add(&bar[XB_TOPGEN], 1u);
            else XB_SPIN(xb_ld(&bar[XB_TOPGEN]) == tg, bar);
            __builtin_amdgcn_fence(__ATOMIC_ACQUIRE, "agent");
            xb_add(&bar[XB_XGEN(b.x)], 1u);
            asm volatile("s_waitcnt vmcnt(0)" ::: "memory");
        } else {
            XB_SPIN(xb_ld(&bar[XB_XGEN(b.x)]) == gen, bar);
            __builtin_amdgcn_fence(__ATOMIC_ACQUIRE, "agent");
            asm volatile("s_waitcnt vmcnt(0)" ::: "memory");
        }
    }
    __syncthreads();
}

DI float bf2f(u16 v) { return __uint_as_float(((unsigned)v) << 16); }
DI float bflo(unsigned w) { return __uint_as_float(w << 16); }
DI float bfhi(unsigned w) { return __uint_as_float(w & 0xffff0000u); }
DI unsigned pack2(float a, float b) { f32x2 v = {a, b}; bf16x2_t r = __builtin_convertvector(v, bf16x2_t); return __builtin_bit_cast(unsigned, r); }
DI u32x2 pack4(f32x4 v) { bf16x4_t r = __builtin_convertvector(v, bf16x4_t); return __builtin_bit_cast(u32x2, r); }
DI float sigmoidf_(float x) { return __builtin_amdgcn_rcpf(1.0f + __expf(-x)); }
DI float gelu_tanh(float x) { const float u = 0.7978845608028654f * (x + 0.044715f * x * x * x); const float e = __expf(2.0f * u); const float th = 1.0f - 2.0f / (e + 1.0f); return 0.5f * x * (1.0f + th); }
#define LP(type, addr) ((LAS type*)(uintptr_t)(addr))
DI s16x4 tr_read(unsigned byte_addr) { return __builtin_amdgcn_ds_read_tr16_b64_v4i16(LP(s16x4, byte_addr)); }
DI s16x4 tr_read_na(LAS s16x4* __restrict__ p) { return __builtin_amdgcn_ds_read_tr16_b64_v4i16(p); }
DI bf16x8 cat8(s16x4 lo, s16x4 hi) { return __builtin_shufflevector(lo, hi, 0, 1, 2, 3, 4, 5, 6, 7); }
#define MFMA16(a, b, c) __builtin_amdgcn_mfma_f32_16x16x32_bf16((a), (b), (c), 0, 0, 0)
DI int trrow(int k) { return k ^ ((k >> 1) & 4); }

DI int lane_id() { int l; asm volatile("v_mbcnt_lo_u32_b32 %0, -1, 0\n\tv_mbcnt_hi_u32_b32 %0, -1, %0" : "=v"(l)); return l; }

struct Params {
    const float* in[27];
    float* out;
    unsigned char* ws;
};
typedef const __attribute__((address_space(4))) Params* KPtr;
DI KPtr kargs() { KPtr p = (KPtr)__builtin_amdgcn_kernarg_segment_ptr(); asm volatile("" : "+s"(p)); return p; }

constexpr int G_BSTRIDE = 544, G_BBUF = 64 * G_BSTRIDE, G_B0 = 0, G_B1 = G_BBUF, G_AREG = 0;
#define OPAQUE_LDS(p) asm volatile("" : "+v"(p))
typedef int i32x4 __attribute__((ext_vector_type(4)));
DI __amdgpu_buffer_rsrc_t mk_rsrc(const void* p) { return __builtin_amdgcn_make_buffer_rsrc((void*)p, 0, 0x7FFFFFF0, 0x00020000); }
DI u32x4 bload16(__amdgpu_buffer_rsrc_t r, unsigned voff, unsigned soff) { return __builtin_bit_cast(u32x4, __builtin_amdgcn_raw_buffer_load_b128(r, (int)voff, (int)soff, 0)); }

template <bool GU, class U, class S, int MF = 8>
DI void gemm_stream(LAS unsigned char* lds, const int wid, int nt, const int ldb, const S& sched) {
    constexpr int ABUF = MF * 4096, G_A0 = 0, G_A1 = ABUF, G_BREG = 2 * ABUF, NG = 2 * MF;
    asm volatile("" : "+s"(nt));
    const int lane = lane_id(), wr = wid >> 2, wc = wid & 3, fr = lane & 15, fq = lane >> 4;
    U cur;
    if (!sched.get(0, cur)) return;
    __amdgpu_buffer_rsrc_t rsB0, rsB1, rsA; unsigned voa0, voa1, voa2, voa3, voa4 = 0;
#define G_SETUP_B(u) do { rsB0 = mk_rsrc((u).b0); rsB1 = mk_rsrc((u).b1); } while (0)
#define G_SETUP_A(u) do { \
        const int _l = lane_id(), sb_ = _l * 16, swz = sb_ ^ (((sb_ >> 9) & 1) << 5); \
        const int R0 = (wid >> 1) * 16 + (swz >> 6), C0 = (wid & 1) * 32 + ((swz & 63) >> 1); \
        rsA = mk_rsrc((u).al.base()); \
        voa0 = (u).al.rowoff(R0) + C0 * 2; voa1 = (u).al.rowoff(R0 + 64) + C0 * 2; voa2 = (u).al.rowoff(R0 + 128) + C0 * 2; voa3 = (u).al.rowoff(R0 + 192) + C0 * 2; \
        if (MF == 9) voa4 = (u).al.rowoff(256 + ((wid >> 1) & 1) * 16 + (swz >> 6)) + C0 * 2;        \
        } while (0)
#define G_SETUP(u) do { G_SETUP_B(u); G_SETUP_A(u); } while (0)
    G_SETUP(cur);
    const int hl = lane >> 5, sc = (lane & 31) * 4;
    const unsigned vob = (unsigned)((2 * wid + hl) * ldb + sc) * 4u;
    const unsigned kstepB = (unsigned)ldb * 64u;
    const int pos0 = (GU ? (sc >> 5) * 64 : (sc & ~31)) + ((sc >> 2) & 1) * 16 + ((sc >> 3) & 3) * 4;
    LAS unsigned char* b_wr = lds + G_BREG + (((2 * wid + hl) ^ (wid & 4)) * G_BSTRIDE) + pos0 * 2; OPAQUE_LDS(b_wr);
    constexpr int SLAB1 = GU ? 64 : 256;
    LAS unsigned char* a_rd = lds + G_AREG + wr * (MF * 2048) + ((fr * 64 + fq * 16) ^ (((fr >> 3) & 1) << 5)); OPAQUE_LDS(a_rd);
    const int q = (lane & 15) >> 2, p = lane & 3;
    LAS unsigned char* b_rd0 = lds + G_BREG + fq * (8 * G_BSTRIDE) + (((fq & 1) * 4 + q) * G_BSTRIDE) + wc * 128 + p * 8; OPAQUE_LDS(b_rd0);
    LAS unsigned char* b_rd1 = lds + G_BREG + fq * (8 * G_BSTRIDE) + ((((fq & 1) ^ 1) * 4 + q) * G_BSTRIDE) + wc * 128 + p * 8; OPAQUE_LDS(b_rd1);

    f32x4 acc[MF][4];
    u32x4 sb[8];
    LAS unsigned char* a_dma = lds + G_AREG + wid * 1024;

#define G_DMA_A(kt, AO) do { G_DMA1(kt, AO, 0); G_DMA1(kt, AO, 1); G_DMA1(kt, AO, 2); G_DMA1(kt, AO, 3); if (MF == 9) G_DMA5(kt, AO); } while (0)
#define G_ISSUE_B(kt) do { const unsigned _sb = (unsigned)(kt) * 4u * kstepB; \
        _Pragma("unroll") for (int _i = 0; _i < 8; ++_i) sb[_i] = bload16(_i < 4 ? rsB0 : rsB1, vob, _sb + (_i & 3) * kstepB); } while (0)
#define G_WRITE_B(BO) do { \
        _Pragma("unroll") for (int _i = 0; _i < 8; ++_i) *(LAS u32x2*)(b_wr + (BO) + (_i & 3) * (16 * G_BSTRIDE) + (_i >> 2) * SLAB1) = pack4(__builtin_bit_cast(f32x4, sb[_i])); } while (0)
#define G_DMA1(kt, AO, pc) __builtin_amdgcn_raw_ptr_buffer_load_lds(rsA, (LAS void*)(a_dma + (AO) + (pc) * 8192), 16, (int)((pc) == 0 ? voa0 : (pc) == 1 ? voa1 : (pc) == 2 ? voa2 : voa3), (int)((unsigned)(kt) * 128u), 0, 0)
#define G_DMA5(kt, AO) __builtin_amdgcn_raw_ptr_buffer_load_lds(rsA, (LAS void*)(lds + G_AREG + (AO) + 32768 + (wid & 3) * 1024), 16, (int)voa4, (int)((unsigned)(kt) * 128u), 0, 0)
#define G_WR1(BO, i) (*(LAS u32x2*)(b_wr + (BO) + ((i) & 3) * (16 * G_BSTRIDE) + ((i) >> 2) * SLAB1) = pack4(__builtin_bit_cast(f32x4, sb[i])))
#define G_LD1(kt, i) (sb[i] = bload16(((i) < 4) ? rsB0 : rsB1, vob, (unsigned)(kt) * 4u * kstepB + (unsigned)((i) & 3) * kstepB))
#define G_RD_A(AO, ks, m) (*(const LAS bf16x8*)(a_rd + (AO) + (m) * 2048 + (ks) * 1024))
#define G_TR(BO, ks, n) cat8(tr_read_na((LAS s16x4*)(b_rd0 + (BO) + (ks) * (32 * G_BSTRIDE) + (n) * 32)), \
                             tr_read_na((LAS s16x4*)(b_rd1 + (BO) + (ks) * (32 * G_BSTRIDE) + (n) * 32)))
#define G_TILE(AR, BR, DO_MEM, BW, AW, kA, HAS_B, kB, HOOK) do { \
        bf16x8 Bf[4], Af[3]; \
        _Pragma("unroll") for (int n = 0; n < 4; ++n) Bf[n] = G_TR(BR, 0, n); \
        Af[0] = G_RD_A(AR, 0, 0); Af[1] = G_RD_A(AR, 0, 1); \
        _Pragma("unroll") for (int g = 0; g < NG; ++g) { const int m = g % MF; \
            if (g < NG - 2) Af[(g + 2) % 3] = G_RD_A(AR, (g + 2) / MF, (g + 2) % MF); \
            if (DO_MEM && g == 0) { G_DMA1(kA, AW, 0); G_DMA1(kA, AW, 1); G_DMA1(kA, AW, 2); G_DMA1(kA, AW, 3); if (MF == 9) G_DMA5(kA, AW); HOOK; } \
            _Pragma("unroll") for (int n = 0; n < 4; ++n) { acc[m][n] = MFMA16(Bf[n], Af[g % 3], acc[m][n]); \
                if (g == MF - 1) Bf[n] = G_TR(BR, 1, n); }            \
            if (DO_MEM && (g & 1) && g < 16) { G_WR1(BW, g >> 1); __builtin_amdgcn_sched_barrier(0); if (HAS_B) G_LD1(kB, g >> 1); } \
            __builtin_amdgcn_sched_barrier(0); } \
    } while (0)
#define G_ENDTILE(VM) do { asm volatile("s_waitcnt vmcnt(" #VM ")" ::: "memory"); \
        asm volatile("s_waitcnt lgkmcnt(0)" ::: "memory"); __builtin_amdgcn_s_barrier(); asm volatile("" ::: "memory"); } while (0)

    __builtin_amdgcn_s_barrier();
    G_DMA_A(0, G_A0); G_ISSUE_B(0); G_WRITE_B(G_B0);
    __builtin_amdgcn_sched_barrier(0);
    G_ISSUE_B(1);
    __builtin_amdgcn_sched_barrier(0);
    G_ENDTILE(8);
    for (int ui = 0;; ++ui) {
#pragma unroll
        for (int m = 0; m < MF; ++m)
#pragma unroll
            for (int n = 0; n < 4; ++n) acc[m][n] = (f32x4){0.f, 0.f, 0.f, 0.f};
        for (int t = 0; t < nt - 2; t += 2) {
            G_TILE(G_A0, G_B0, true, G_B1, G_A1, t + 1, true, t + 2, (void)0);
            G_ENDTILE(8);
            G_TILE(G_A1, G_B1, true, G_B0, G_A0, t + 2, true, t + 3, (void)0);
            G_ENDTILE(8);
        }
        U nxt = cur;
        const bool has_next = sched.get(ui + 1, nxt);
        G_SETUP_B(nxt);
        G_TILE(G_A0, G_B0, true, G_B1, G_A1, nt - 1, true, 0, G_SETUP_A(nxt));
        G_ENDTILE(8);
        G_TILE(G_A1, G_B1, true, G_B0, G_A0, 0, true, 1, (void)0);
        G_ENDTILE(8);
        { const int l2 = lane_id(); cur.ep(acc, wr, wc, l2 & 15, l2 >> 4); }
        if (!has_next) break;
        cur = nxt;
    }
    asm volatile("s_waitcnt vmcnt(0)" ::: "memory");
#undef G_SETUP_A
#undef G_SETUP_B
#undef G_SETUP
#undef G_DMA_A
#undef G_ISSUE_B
#undef G_WRITE_B
#undef G_DMA1
#undef G_DMA5
#undef G_WR1
#undef G_LD1
#undef G_RD_A
#undef G_TR
#undef G_TILE
#undef G_ENDTILE
}

struct ARows { const u16* b; int lda; DI const void* base() const { return b; } DI unsigned rowoff(int r) const { return (unsigned)(r * lda) * 2u; } };
struct AGather { const u16* x; const int* ids; int m0, cnt; DI const void* base() const { return x; }
    DI unsigned rowoff(int r) const { int i = m0 + r; i = i < cnt ? i : cnt - 1;
        const unsigned v = (unsigned)__builtin_amdgcn_raw_buffer_load_b32(__builtin_amdgcn_make_buffer_rsrc((void*)ids, 0, 0x7FFFFFF0, 0x00020000), i * 4, 0, 0);
        return (v >> 2) * (unsigned)(D * 2); } };

struct Ctx {
    LAS unsigned char* lds; unsigned char* ws; unsigned* ctl; int wid, bid, G;
};

DI void p0_prologue(const Ctx& c) {
    const KPtr kp = kargs();
    const int tid = c.wid * 64 + lane_id();
    const size_t gt = (size_t)c.bid * NTHR + tid, gs = (size_t)c.G * NTHR;
    { const f32x4* src = (const f32x4*)kp->in[0]; u32x4* dst = (u32x4*)(c.ws + WS_XB);
      for (size_t i = gt; i < (size_t)T * D / 8; i += gs) { const f32x4 a = src[2 * i], b = src[2 * i + 1]; const u32x2 lo = pack4(a), hi = pack4(b); dst[i] = (u32x4){lo.x, lo.y, hi.x, hi.y}; } }
    { const f32x4* src = (const f32x4*)kp->in[1]; u32x4* dst = (u32x4*)(c.ws + WS_PB);
      for (size_t i = gt; i < (size_t)T * PLE / 8; i += gs) { const f32x4 a = src[2 * i], b = src[2 * i + 1]; const u32x2 lo = pack4(a), hi = pack4(b); dst[i] = (u32x4){lo.x, lo.y, hi.x, hi.y}; } }
    { f32x2* rope = (f32x2*)(c.ws + WS_ROPE);
      for (size_t i = gt; i < (size_t)SEQ * 64; i += gs) { const int pos = (int)(i >> 6), k = (int)(i & 63);
        const float inv = exp2f(-(float)k * (13.287712379549449f / 64.0f));
        const float ang = (float)pos * inv;
        double rv = (double)ang * 0.15915494309189535; rv -= floor(rv);
        const float f = (float)rv;
        rope[i] = (f32x2){__builtin_amdgcn_cosf(f), __builtin_amdgcn_sinf(f)}; } }
}

struct EpiProj { u16* out; int row0, col0;
    DI void operator()(const f32x4 (&acc)[8][4], int wr, int wc, int fr, int fq) const {
#pragma unroll
        for (int m = 0; m < 8; ++m) { u16* rp = out + (size_t)(row0 + wr * 128 + m * 16 + fr) * INC + col0 + wc * 64 + 8 * fq;
#pragma unroll
            for (int h = 0; h < 2; ++h) { const u32x2 lo = pack4(acc[m][2 * h]), hi = pack4(acc[m][2 * h + 1]); *(u32x4*)(rp + h * 32) = (u32x4){lo.x, lo.y, hi.x, hi.y}; } }
    } };
struct EpiPle { u16* out; float* ssq; int row0, ntile;
    DI void operator()(const f32x4 (&acc)[8][4], int wr, int wc, int fr, int fq) const {
#pragma unroll
        for (int m = 0; m < 8; ++m) { const int row = row0 + wr * 128 + m * 16 + fr; u16* rp = out + (size_t)row * D + ntile * 256 + wc * 64 + 8 * fq; float s = 0.f;
#pragma unroll
            for (int n = 0; n < 4; ++n) { const f32x4 v = acc[m][n]; s += (v[0] * v[0] + v[1] * v[1]) + (v[2] * v[2] + v[3] * v[3]); }
#pragma unroll
            for (int h = 0; h < 2; ++h) { const u32x2 lo = pack4(acc[m][2 * h]), hi = pack4(acc[m][2 * h + 1]); *(u32x4*)(rp + h * 32) = (u32x4){lo.x, lo.y, hi.x, hi.y}; }
            s += __shfl_xor(s, 16); s += __shfl_xor(s, 32);
            if (fq == 0) ssq[(size_t)row * 32 + ntile * 4 + wc] = s; }
    } };
struct EpiY1 { const u16* x; u16* y; int row0, col0;
    DI void operator()(const f32x4 (&acc)[8][4], int wr, int wc, int fr, int fq) const {
#pragma unroll
        for (int m = 0; m < 8; ++m) { const size_t off = (size_t)(row0 + wr * 128 + m * 16 + fr) * D + col0 + wc * 64 + 8 * fq;
#pragma unroll
            for (int h = 0; h < 2; ++h) { const u32x4 xr = *(const u32x4*)(x + off + h * 32);
                const f32x4 x0 = {bflo(xr.x), bfhi(xr.x), bflo(xr.y), bfhi(xr.y)}, x1 = {bflo(xr.z), bfhi(xr.z), bflo(xr.w), bfhi(xr.w)};
                const u32x2 lo = pack4(x0 * DN_ALPHA + acc[m][2 * h]), hi = pack4(x1 * DN_ALPHA + acc[m][2 * h + 1]); *(u32x4*)(y + off + h * 32) = (u32x4){lo.x, lo.y, hi.x, hi.y}; } }
    } };
struct EpiHid { u16* hid; const float* bg; const float* bu; int row0, hc0;
    template <int MF> DI void operator()(const f32x4 (&acc)[MF][4], int wr, int wc, int fr, int fq) const {
        const int hc = hc0 + wc * 32 + 8 * fq;
        f32x4 bgv[2], buv[2];
#pragma unroll
        for (int n = 0; n < 2; ++n) { bgv[n] = *(const f32x4*)(bg + hc + 4 * n); buv[n] = *(const f32x4*)(bu + hc + 4 * n); }
#pragma unroll
        for (int m = 0; m < MF; ++m) { u16* rp = hid + (size_t)(row0 + wr * (16 * MF) + m * 16 + fr) * D + hc; u32x2 w[2];
#pragma unroll
            for (int n = 0; n < 2; ++n) { f32x4 g = acc[m][n] + bgv[n], u = acc[m][n + 2] + buv[n], h;
#pragma unroll
                for (int j = 0; j < 4; ++j) { const float gt = fminf(g[j], 7.0f); const float up = fminf(fmaxf(u[j], -7.0f), 7.0f); h[j] = (up + 1.0f) * gt * sigmoidf_(1.702f * gt); }
                w[n] = pack4(h); }
            *(u32x4*)rp = (u32x4){w[0].x, w[0].y, w[1].x, w[1].y}; }
    } };
struct EpiDown { u16* ybuf; const float* bd; const int* ids; const float* gts; int m0, cnt, col0;
    template <int MF> DI void operator()(const f32x4 (&acc)[MF][4], int wr, int wc, int fr, int fq) const {
        f32x4 bv[4];
#pragma unroll
        for (int n = 0; n < 4; ++n) bv[n] = *(const f32x4*)(bd + col0 + wc * 64 + 32 * (n >> 1) + 8 * fq + 4 * (n & 1));
#pragma unroll
        for (int m = 0; m < MF; ++m) { const int i = m0 + wr * (16 * MF) + m * 16 + fr;
            if (i < cnt) { const int id = ids[i]; const float g = gts[i]; u16* rp = ybuf + (size_t)id * D + col0 + wc * 64 + 8 * fq;
#pragma unroll
                for (int h = 0; h < 2; ++h) { const u32x2 lo = pack4((acc[m][2 * h] + bv[2 * h]) * g), hi = pack4((acc[m][2 * h + 1] + bv[2 * h + 1]) * g);
                    *(u32x4*)(rp + h * 32) = (u32x4){lo.x, lo.y, hi.x, hi.y}; } } }
    } };
struct EpiOut { float* out; const u16* x2b; const u16* ep; const float* rse; const float* pnw; int row0, col0;
    DI void operator()(const f32x4 (&acc)[8][4], int wr, int wc, int fr, int fq) const {
        f32x4 wv[4];
#pragma unroll
        for (int n = 0; n < 4; ++n) wv[n] = *(const f32x4*)(pnw + col0 + wc * 64 + 32 * (n >> 1) + 8 * fq + 4 * (n & 1));
#pragma unroll
        for (int m = 0; m < 8; ++m) { const int row = row0 + wr * 128 + m * 16 + fr; const float rs = rse[row]; const size_t off = (size_t)row * D + col0 + wc * 64 + 8 * fq;
#pragma unroll
            for (int h = 0; h < 2; ++h) { const u32x4 xr = *(const u32x4*)(x2b + off + h * 32), er = *(const u32x4*)(ep + off + h * 32);
                const unsigned xw[4] = {xr.x, xr.y, xr.z, xr.w}, ew[4] = {er.x, er.y, er.z, er.w};
#pragma unroll
                for (int q = 0; q < 2; ++q) { const f32x4 a = acc[m][2 * h + q]; const f32x4 w4 = wv[2 * h + q]; f32x4 o;
                    o[0] = bflo(xw[2 * q]) + sigmoidf_(a[0]) * bflo(ew[2 * q]) * rs * w4[0]; o[1] = bfhi(xw[2 * q]) + sigmoidf_(a[1]) * bfhi(ew[2 * q]) * rs * w4[1];
                    o[2] = bflo(xw[2 * q + 1]) + sigmoidf_(a[2]) * bflo(ew[2 * q + 1]) * rs * w4[2]; o[3] = bfhi(xw[2 * q + 1]) + sigmoidf_(a[3]) * bfhi(ew[2 * q + 1]) * rs * w4[3];
                    *(f32x4*)(out + off + h * 32 + 4 * q) = o; } } }
    } };

DI bool deal_tiles(int bid, int G, int nM, int nN, int i, int& pm, int& pn) {
    const int x = bid & 7, r = bid >> 3, W = G >> 3;
    const int mper = nM >> 3;
    const int q = i * W + r;
    if (q >= mper * nN) return false;
    pm = x * mper + (q % mper); pn = q / mper; return true;
}

template <class EP> struct UnitD { ARows al; const float* b0; const float* b1; EP ep; DI int rows() const { return 256; } };
struct SchedProj { int bid, G; const u16* xb; const float* w; u16* proj;
    DI bool get(int i, UnitD<EpiProj>& u) const { int pm, pn; if (!deal_tiles(bid, G, T / 256, INC / 256, i, pm, pn)) return false;
        u.al = ARows{xb + (size_t)pm * 256 * D, D}; u.b0 = w + pn * 256; u.b1 = u.b0 + 128; u.ep = EpiProj{proj, pm * 256, pn * 256}; return true; } };
struct SchedPle { int bid, G; const u16* pb; const float* w; u16* epo; float* ssq;
    DI bool get(int i, UnitD<EpiPle>& u) const { int pm, pn; if (!deal_tiles(bid, G, T / 256, D / 256, i, pm, pn)) return false;
        u.al = ARows{pb + (size_t)pm * 256 * PLE, PLE}; u.b0 = w + pn * 256; u.b1 = u.b0 + 128; u.ep = EpiPle{epo, ssq, pm * 256, pn}; return true; } };
struct SchedY1 { int bid, G; const u16* mx; const float* w; const u16* x; u16* y;
    DI bool get(int i, UnitD<EpiY1>& u) const { int pm, pn; if (!deal_tiles(bid, G, T / 256, D / 256, i, pm, pn)) return false;
        u.al = ARows{mx + (size_t)pm * 256 * D, D}; u.b0 = w + pn * 256; u.b1 = u.b0 + 128; u.ep = EpiY1{x, y, pm * 256, pn * 256}; return true; } };
struct SchedOut { int bid, G; const u16* xb; const float* w; float* out; const u16* epi; const float* rse; const float* pnw;
    DI bool get(int i, UnitD<EpiOut>& u) const { int pm, pn; if (!deal_tiles(bid, G, T / 256, D / 256, i, pm, pn)) return false;
        u.al = ARows{xb + (size_t)pm * 256 * D, D}; u.b0 = w + pn * 256; u.b1 = u.b0 + 128; u.ep = EpiOut{out, xb, epi, rse, pnw, pm * 256, pn * 256}; return true; } };

DI void p1_gemm(const Ctx& c) {
    const KPtr kp = kargs();
    { const SchedProj S{c.bid, c.G, (const u16*)(c.ws + WS_XB), kp->in[2], (u16*)(c.ws + WS_PROJ)};
      gemm_stream<false, UnitD<EpiProj>>(c.lds, c.wid, D / 64, INC, S); }
    { const SchedPle S{c.bid, c.G, (const u16*)(c.ws + WS_PB), kp->in[24], (u16*)(c.ws + WS_EP), (float*)(c.ws + WS_SSQ)};
      gemm_stream<false, UnitD<EpiPle>>(c.lds, c.wid, PLE / 64, D, S); }
}
DI void p3_gemm(const Ctx& c) {
    const KPtr kp = kargs();
    const SchedY1 S{c.bid, c.G, (const u16*)(c.ws + WS_MIXED), kp->in[11], (const u16*)(c.ws + WS_XB), (u16*)(c.ws + WS_Y1)};
    gemm_stream<false, UnitD<EpiY1>>(c.lds, c.wid, D / 64, D, S);
}
DI void p8_gemm(const Ctx& c) {
    const KPtr kp = kargs();
    const SchedOut S{c.bid, c.G, (const u16*)(c.ws + WS_X2B), kp->in[26], kp->out, (const u16*)(c.ws + WS_EP), (const float*)(c.ws + WS_RSE), kp->in[25]};
    gemm_stream<false, UnitD<EpiOut>>(c.lds, c.wid, D / 64, D, S);
}

constexpr int MOE_MF = 9, MOE_BM = 32 * MOE_MF;
constexpr int MS_OFF = 143424;
template <bool ALL>
DI void moe_build_sched(const Ctx& c) {
    LAS int* S = (LAS int*)(c.lds + MS_OFF);
    __syncthreads();
    if (c.wid == 0) {
        const int lane = lane_id(), x = c.bid & 7;
        const int myc = (lane < NE) ? (int)c.ctl[CW_CNT + 64 * lane] : 0;
        int load[8] = {0, 0, 0, 0, 0, 0, 0, 0}; int hb = 0, nown = 0;
#pragma unroll
        for (int e = 0; e < NE; ++e) { const int cn = __builtin_amdgcn_readlane(myc, e), mc = (cn + MOE_BM - 1) / MOE_BM;
            int best = 0, bl = load[0];
#pragma unroll
            for (int j = 1; j < 8; ++j) { const bool lt = load[j] < bl; bl = lt ? load[j] : bl; best = lt ? j : best; }
#pragma unroll
            for (int j = 0; j < 8; ++j) load[j] += (j == best) ? mc : 0;
            if ((ALL || best == x) && mc > 0) { if (lane == 0) { S[8 + 4 * nown] = e; S[9 + 4 * nown] = mc; S[10 + 4 * nown] = cn; S[11 + 4 * nown] = hb; } ++nown; }
            hb += mc * MOE_BM; }
        if (lane == 0) S[0] = nown;
    }
    __syncthreads();
}
DI bool moe_find(const Ctx& c, int qi, int NT, int& e, int& nt, int& mt, int& cn, int& hb) {
    LAS int* S = (LAS int*)(c.lds + MS_OFF);
    const int nown = __builtin_amdgcn_readfirstlane(S[0]); int accu = 0;
    for (int k = 0; k < nown; ++k) { const int mc = __builtin_amdgcn_readfirstlane(S[9 + 4 * k]);
        if (qi < accu + NT * mc) { const int loc = qi - accu; nt = loc / mc; mt = loc - nt * mc;
            e = __builtin_amdgcn_readfirstlane(S[8 + 4 * k]); cn = __builtin_amdgcn_readfirstlane(S[10 + 4 * k]); hb = __builtin_amdgcn_readfirstlane(S[11 + 4 * k]); return true; }
        accu += NT * mc; }
    return false;
}
struct UnitUp { AGather al; const float* b0; const float* b1; EpiHid ep; int nrows; DI int rows() const { return nrows; } };
struct SchedUp { const Ctx& c; int r, W; const u16* x1b; const int* lid; const float* wg; const float* wu; const float* bg; const float* bu; u16* hid;
    DI bool get(int i, UnitUp& u) const { int e, nt, mt, cn, hb; if (!moe_find(c, r + i * W, 2, e, nt, mt, cn, hb)) return false; nt = (c.bid & 7) + 8 * nt;
        u.al = AGather{x1b, lid + e * LIST_CAP, mt * MOE_BM, cn}; u.b0 = wg + (size_t)e * D * D + nt * 128; u.b1 = wu + (size_t)e * D * D + nt * 128;
        u.ep = EpiHid{hid, bg + e * D, bu + e * D, hb + mt * MOE_BM, nt * 128}; u.nrows = cn - mt * MOE_BM; return true; } };
struct UnitDown { ARows al; const float* b0; const float* b1; EpiDown ep; int nrows; DI int rows() const { return nrows; } };
struct SchedDown { const Ctx& c; int r, W; const u16* hid; const int* lid; const float* lgt; const float* wd; const float* bd; u16* ybuf;
    DI bool get(int i, UnitDown& u) const { int e, nt, mt, cn, hb; if (!moe_find(c, r + i * W, 8, e, nt, mt, cn, hb)) return false;
        u.al = ARows{hid + (size_t)(hb + mt * MOE_BM) * D, D}; u.b0 = wd + (size_t)e * D * D + nt * 256; u.b1 = u.b0 + 128;
        u.ep = EpiDown{ybuf, bd + e * D, lid + e * LIST_CAP, lgt + e * LIST_CAP, mt * MOE_BM, cn, nt * 256}; u.nrows = cn - mt * MOE_BM; return true; } };
DI void p5_moe_up(const Ctx& c) {
    const KPtr kp = kargs();
    moe_build_sched<true>(c);
    const SchedUp S{c, c.bid >> 3, c.G >> 3, (const u16*)(c.ws + WS_X1B), (const int*)(c.ws + WS_LID), kp->in[16], kp->in[18], kp->in[17], kp->in[19], (u16*)(c.ws + WS_HID)};
    gemm_stream<true, UnitUp, SchedUp, MOE_MF>(c.lds, c.wid, D / 64, D, S);
}
DI void p6_moe_down(const Ctx& c) {
    const KPtr kp = kargs();
    moe_build_sched<false>(c);
    const SchedDown S{c, c.bid >> 3, c.G >> 3, (const u16*)(c.ws + WS_HID), (const int*)(c.ws + WS_LID), (const float*)(c.ws + WS_LGT), kp->in[20], kp->in[21], (u16*)(c.ws + WS_YBUF)};
    gemm_stream<false, UnitDown, SchedDown, MOE_MF>(c.lds, c.wid, D / 64, D, S);
}

DI float head_log_gamma(int h) { return log1pf(-exp2f(-5.0f - (float)h)); }

template <bool TRIMG>
DI void stage_rope(const Ctx& c, unsigned dst, int stride, int t0, int col0, int pos0, float scale, float lg, bool kdec) {
    const u16* proj = (const u16*)(c.ws + WS_PROJ); const f32x2* rope = (const f32x2*)(c.ws + WS_ROPE); const int tid = c.wid * 64 + lane_id();
#pragma unroll
    for (int it = 0; it < 2; ++it) { const int item = tid + it * NTHR, j = item >> 3, pc = item & 7, dd = pc * 8;
        const u16* rp = proj + (size_t)(t0 + j) * INC + col0 + dd;
        const u32x4 a = *(const u32x4*)rp, b = *(const u32x4*)(rp + 64);
        const f32x4* cs = (const f32x4*)(rope + (size_t)(pos0 + j) * 64 + dd);
        const f32x4 c0 = cs[0], c1 = cs[1], c2 = cs[2], c3 = cs[3];
        const float sc = kdec ? scale * __expf((float)(127 - j) * lg) : scale;
        float x1[8] = {bflo(a.x), bfhi(a.x), bflo(a.y), bfhi(a.y), bflo(a.z), bfhi(a.z), bflo(a.w), bfhi(a.w)};
        float x2[8] = {bflo(b.x), bfhi(b.x), bflo(b.y), bfhi(b.y), bflo(b.z), bfhi(b.z), bflo(b.w), bfhi(b.w)};
        const float cc[8] = {c0[0], c0[2], c1[0], c1[2], c2[0], c2[2], c3[0], c3[2]};
        const float ss[8] = {c0[1], c0[3], c1[1], c1[3], c2[1], c2[3], c3[1], c3[3]};
        float o1[8], o2[8];
#pragma unroll
        for (int k = 0; k < 8; ++k) { o1[k] = (x1[k] * cc[k] - x2[k] * ss[k]) * sc; o2[k] = (x1[k] * ss[k] + x2[k] * cc[k]) * sc; }
        const int row = TRIMG ? trrow(j) : j;
        *LP(u32x4, dst + row * stride + dd * 2) = (u32x4){pack2(o1[0], o1[1]), pack2(o1[2], o1[3]), pack2(o1[4], o1[5]), pack2(o1[6], o1[7])};
        *LP(u32x4, dst + row * stride + (64 + dd) * 2) = (u32x4){pack2(o2[0], o2[1]), pack2(o2[2], o2[3]), pack2(o2[4], o2[5]), pack2(o2[6], o2[7])}; }
}
template <bool TRIMG>
DI void stage_plain(const Ctx& c, unsigned dst, int stride, int t0, int col0) {
    const u16* proj = (const u16*)(c.ws + WS_PROJ); const int tid = c.wid * 64 + lane_id();
#pragma unroll
    for (int it = 0; it < 4; ++it) { const int item = tid + it * NTHR, j = item >> 4, ch = item & 15;
        const u32x4 a = *(const u32x4*)(proj + (size_t)(t0 + j) * INC + col0 + ch * 8);
        const int row = TRIMG ? trrow(j) : j;
        *LP(u32x4, dst + row * stride + ch * 16) = a; }
}
DI bf16x8 tr_frag(unsigned img, int stride, int k0, int n0, int lane) {
    const int fq = lane >> 4, q = (lane & 15) >> 2, p = lane & 3;
    const int kb = k0 + 8 * fq, par = (kb >> 3) & 1;
    const unsigned a0 = img + (kb + ((par * 4) + q)) * stride + n0 * 2 + p * 8;
    const unsigned a1 = img + (kb + (((par ^ 1) * 4) + q)) * stride + n0 * 2 + p * 8;
    return cat8(tr_read(a0), tr_read(a1));
}
DI bf16x8 row_frag(unsigned img, int stride, int r0, int k0, int lane) {
    return *LP(const bf16x8, img + (r0 + (lane & 15)) * stride + (k0 + 8 * (lane >> 4)) * 2);
}

constexpr int RS = 272, TS = 288;
constexpr int IMG_R = 128 * RS, IMG_T = 128 * TS;

DI void ret_kv_unit(const Ctx& c, int u) {
    const int h = u & 7, n = (u >> 3) & 15, b = u >> 7;
    const int t0 = b * SEQ + n * CHUNK; const float lg = head_log_gamma(h);
    const unsigned base = (unsigned)(size_t)c.lds, Kimg = base, Vimg = base + IMG_T;
    __syncthreads();
    stage_rope<true>(c, Kimg, TS, t0, RW + h * 128, n * CHUNK, 0.08838834764831845f, lg, true);
    stage_plain<true>(c, Vimg, TS, t0, 2 * RW + h * 128);
    __syncthreads();
    f32x4 acc[8];
#pragma unroll
    for (int i = 0; i < 8; ++i) acc[i] = (f32x4){0.f, 0.f, 0.f, 0.f};
    const int d0 = c.wid * 16, lane = lane_id();
#pragma unroll
    for (int ks = 0; ks < 4; ++ks) { const bf16x8 kf = tr_frag(Kimg, TS, ks * 32, d0, lane);
#pragma unroll
        for (int ef = 0; ef < 8; ++ef) acc[ef] = MFMA16(tr_frag(Vimg, TS, ks * 32, ef * 16, lane), kf, acc[ef]); }
    u16* kv = (u16*)(c.ws + WS_KV) + (size_t)((b * NHEAD + h) * NCH + n) * 16384;
    const int d = d0 + (lane & 15), fq = lane >> 4;
#pragma unroll
    for (int ef = 0; ef < 8; ++ef) *(u32x2*)(kv + d * 128 + ef * 16 + 4 * fq) = pack4(acc[ef]);
}

DI void ret_out_unit(const Ctx& c, int u) {
    const KPtr kp = kargs();
    const int h = u & 7, n = (u >> 3) & 15, b = u >> 7;
    const int t0 = b * SEQ + n * CHUNK; const float lg = head_log_gamma(h);
    const unsigned base = (unsigned)(size_t)c.lds, Qimg = base, Kimg = base + IMG_R, Vimg = base + 2 * IMG_R, Simg = base + 2 * IMG_R + IMG_T;
    const u16* proj = (const u16*)(c.ws + WS_PROJ);
    __syncthreads();
    stage_rope<false>(c, Qimg, RS, t0, h * 128, n * CHUNK, 1.0f, lg, false);
    stage_rope<false>(c, Kimg, RS, t0, RW + h * 128, n * CHUNK, 0.08838834764831845f, lg, false);
    stage_plain<true>(c, Vimg, TS, t0, 2 * RW + h * 128);
    {
        const float cd = __expf(128.0f * lg);
        const u16* kv = (const u16*)(c.ws + WS_KV) + (size_t)((b * NHEAD + h) * NCH) * 16384; const int tid = c.wid * 64 + lane_id();
        f32x4 s[8];
#pragma unroll
        for (int i = 0; i < 8; ++i) s[i] = (f32x4){0.f, 0.f, 0.f, 0.f};
#pragma unroll 4
        for (int m = 0; m < n; ++m) { const u32x2* src = (const u32x2*)(kv + (size_t)m * 16384);
#pragma unroll
            for (int i = 0; i < 8; ++i) { const u32x2 v = src[tid + i * NTHR]; s[i] = s[i] * cd + (f32x4){bflo(v.x), bfhi(v.x), bflo(v.y), bfhi(v.y)}; } }
#pragma unroll
        for (int i = 0; i < 8; ++i) { const int idx = tid + i * NTHR, dd = idx >> 5, e4 = (idx & 31) * 4;
            *LP(u32x2, Simg + trrow(dd) * TS + e4 * 2) = pack4(s[i]); }
    }
    __syncthreads();
    const int w = c.wid, lane = lane_id(), fq = lane >> 4, il = 16 * w + (lane & 15);
    bf16x8 qf[4];
#pragma unroll
    for (int ks = 0; ks < 4; ++ks) qf[ks] = row_frag(Qimg, RS, 16 * w, ks * 32, lane);
    f32x4 acc[8];
#pragma unroll
    for (int i = 0; i < 8; ++i) acc[i] = (f32x4){0.f, 0.f, 0.f, 0.f};
#pragma unroll
    for (int ks = 0; ks < 4; ++ks)
#pragma unroll
        for (int ef = 0; ef < 8; ++ef) acc[ef] = MFMA16(tr_frag(Simg, TS, ks * 32, ef * 16, lane), qf[ks], acc[ef]);
    { const float qd = __expf((float)(il + 1) * lg);
#pragma unroll
      for (int ef = 0; ef < 8; ++ef) acc[ef] *= qd; }
    f32x4 sc[8];
#pragma unroll
    for (int jf = 0; jf < 8; ++jf) { sc[jf] = (f32x4){0.f, 0.f, 0.f, 0.f};
        if (jf <= w) {
#pragma unroll
            for (int ks = 0; ks < 4; ++ks) sc[jf] = MFMA16(row_frag(Kimg, RS, jf * 16, ks * 32, lane), qf[ks], sc[jf]);
#pragma unroll
            for (int r = 0; r < 4; ++r) { const int j = jf * 16 + 4 * fq + r; sc[jf][r] = (il >= j) ? sc[jf][r] * __expf((float)(il - j) * lg) : 0.f; }
        } }
    __syncthreads();
    const unsigned Pimg = Kimg;
#pragma unroll
    for (int jf = 0; jf < 8; ++jf) *LP(u32x2, Pimg + il * RS + (jf * 16 + 4 * fq) * 2) = pack4(sc[jf]);
    __syncthreads();
#pragma unroll
    for (int ks = 0; ks < 4; ++ks) if (ks <= (w >> 1)) { const bf16x8 pf = row_frag(Pimg, RS, 16 * w, ks * 32, lane);
#pragma unroll
        for (int ef = 0; ef < 8; ++ef) acc[ef] = MFMA16(tr_frag(Vimg, TS, ks * 32, ef * 16, lane), pf, acc[ef]); }
    float s = 0.f;
#pragma unroll
    for (int ef = 0; ef < 8; ++ef) s += (acc[ef][0] + acc[ef][1]) + (acc[ef][2] + acc[ef][3]);
    s += __shfl_xor(s, 16); s += __shfl_xor(s, 32);
    const float mean = s * (1.0f / 128.0f); float qv = 0.f;
#pragma unroll
    for (int ef = 0; ef < 8; ++ef) { const f32x4 dlt = acc[ef] - mean; qv += (dlt[0] * dlt[0] + dlt[1] * dlt[1]) + (dlt[2] * dlt[2] + dlt[3] * dlt[3]); }
    qv += __shfl_xor(qv, 16); qv += __shfl_xor(qv, 32);
    const float rstd = rsqrtf(qv * (1.0f / 128.0f) + LN_EPS);
    const float* gnw = kp->in[3] + h * 128; u16* mixed = (u16*)(c.ws + WS_MIXED);
    const size_t trow = (size_t)(t0 + il);
#pragma unroll
    for (int ef = 0; ef < 8; ++ef) { const int e = ef * 16 + 4 * fq; const f32x4 gw = *(const f32x4*)(gnw + e);
        const u32x2 gb = *(const u32x2*)(proj + trow * INC + 3 * RW + h * 128 + e);
        const float g[4] = {bflo(gb.x), bfhi(gb.x), bflo(gb.y), bfhi(gb.y)}; f32x4 o;
#pragma unroll
        for (int r = 0; r < 4; ++r) o[r] = (acc[ef][r] - mean) * rstd * gw[r] * (g[r] * sigmoidf_(g[r]));
        *(u32x2*)(mixed + trow * D + h * 128 + e) = pack4(o); }
}

constexpr int LAS_STR = 132;
DI void lru_local_unit(const Ctx& c, int u) {
    const KPtr kp = kargs();
    const int blk = u & 7, n = (u >> 3) & 15, b = u >> 7;
    const int t0 = b * SEQ + n * CHUNK, cb = blk * 128;
    const unsigned base = (unsigned)(size_t)c.lds, Aimg = base, Waimg = base + IMG_R, Wximg = base + IMG_R + IMG_T;
    const u16* proj = (const u16*)(c.ws + WS_PROJ);
    const float* conv_w = kp->in[4]; const float* conv_b = kp->in[5];
    __syncthreads();
    {
        const float* wa = kp->in[6] + (size_t)blk * 16384; const float* wx = kp->in[8] + (size_t)blk * 16384;
        const int tid = c.wid * 64 + lane_id();
#pragma unroll
        for (int it = 0; it < 8; ++it) { const int item = tid + it * NTHR, i = item >> 5, jc = item & 31;
            *LP(u32x2, Waimg + trrow(i) * TS + jc * 8) = pack4(*(const f32x4*)(wa + i * 128 + jc * 4));
            *LP(u32x2, Wximg + trrow(i) * TS + jc * 8) = pack4(*(const f32x4*)(wx + i * 128 + jc * 4)); }
    }
    {
        const int tid = c.wid * 64 + lane_id(); const int tr = tid >> 4, cc = tid & 15, ch = cb + cc * 8;
        float xin[7][8];
#pragma unroll
        for (int rr = 0; rr < 7; ++rr) { const int tl = 4 * tr - 3 + rr;
            if (n == 0 && tl < 0) {
#pragma unroll
                for (int k = 0; k < 8; ++k) xin[rr][k] = 0.f;
            } else { const u32x4 v = *(const u32x4*)(proj + (size_t)(t0 + tl) * INC + 4 * RW + ch);
                xin[rr][0] = bflo(v.x); xin[rr][1] = bfhi(v.x); xin[rr][2] = bflo(v.y); xin[rr][3] = bfhi(v.y); xin[rr][4] = bflo(v.z); xin[rr][5] = bfhi(v.z); xin[rr][6] = bflo(v.w); xin[rr][7] = bfhi(v.w); } }
        float wv[4][8], bv[8];
#pragma unroll
        for (int j = 0; j < 4; ++j) { const f32x4 w0 = *(const f32x4*)(conv_w + j * LW + ch), w1 = *(const f32x4*)(conv_w + j * LW + ch + 4);
            wv[j][0] = w0[0]; wv[j][1] = w0[1]; wv[j][2] = w0[2]; wv[j][3] = w0[3]; wv[j][4] = w1[0]; wv[j][5] = w1[1]; wv[j][6] = w1[2]; wv[j][7] = w1[3]; }
        { const f32x4 b0 = *(const f32x4*)(conv_b + ch), b1 = *(const f32x4*)(conv_b + ch + 4); bv[0] = b0[0]; bv[1] = b0[1]; bv[2] = b0[2]; bv[3] = b0[3]; bv[4] = b1[0]; bv[5] = b1[1]; bv[6] = b1[2]; bv[7] = b1[3]; }
#pragma unroll
        for (int r = 0; r < 4; ++r) { float o[8];
#pragma unroll
            for (int k = 0; k < 8; ++k) o[k] = bv[k] + wv[0][k] * xin[r][k] + wv[1][k] * xin[r + 1][k] + wv[2][k] * xin[r + 2][k] + wv[3][k] * xin[r + 3][k];
            *LP(u32x4, Aimg + (4 * tr + r) * RS + cc * 16) = (u32x4){pack2(o[0], o[1]), pack2(o[2], o[3]), pack2(o[4], o[5]), pack2(o[6], o[7])}; }
    }
    __syncthreads();
    const int wr = c.wid >> 2, wc = c.wid & 3; int lane = lane_id(); int fr = lane & 15, fq = lane >> 4;
    f32x4 aR[4][2], aG[4][2];
#pragma unroll
    for (int m = 0; m < 4; ++m)
#pragma unroll
        for (int nn = 0; nn < 2; ++nn) { aR[m][nn] = (f32x4){0.f, 0.f, 0.f, 0.f}; aG[m][nn] = (f32x4){0.f, 0.f, 0.f, 0.f}; }
#pragma unroll
    for (int ks = 0; ks < 4; ++ks) { bf16x8 xf[4];
#pragma unroll
        for (int m = 0; m < 4; ++m) xf[m] = row_frag(Aimg, RS, wr * 64 + m * 16, ks * 32, lane);
#pragma unroll
        for (int nn = 0; nn < 2; ++nn) { const bf16x8 fa = tr_frag(Waimg, TS, ks * 32, wc * 32 + nn * 16, lane), fx = tr_frag(Wximg, TS, ks * 32, wc * 32 + nn * 16, lane);
#pragma unroll
            for (int m = 0; m < 4; ++m) { aR[m][nn] = MFMA16(fa, xf[m], aR[m][nn]); aG[m][nn] = MFMA16(fx, xf[m], aG[m][nn]); } } }
    u32x2 xcv[2][4];
#pragma unroll
    for (int nn = 0; nn < 2; ++nn)
#pragma unroll
        for (int m = 0; m < 4; ++m) xcv[nn][m] = *LP(const u32x2, Aimg + (wr * 64 + m * 16 + fr) * RS + (wc * 32 + nn * 16 + 4 * fq) * 2);
    __syncthreads();
    lane = lane_id(); fr = lane & 15; fq = lane >> 4;
    LAS float* LA = (LAS float*)c.lds; LAS float* LB = LA + 128 * LAS_STR;
    const float* ba = kp->in[7] + cb; const float* bx_ = kp->in[9] + cb; const float* lam = kp->in[10] + cb;
#pragma unroll
    for (int nn = 0; nn < 2; ++nn) { const int cl = wc * 32 + nn * 16 + 4 * fq;
        const f32x4 bav = *(const f32x4*)(ba + cl), bxv = *(const f32x4*)(bx_ + cl), lmv = *(const f32x4*)(lam + cl);
        f32x4 lsg;
#pragma unroll
        for (int r = 0; r < 4; ++r) lsg[r] = -log1pf(__expf(-lmv[r]));
#pragma unroll
        for (int m = 0; m < 4; ++m) { const int tl = wr * 64 + m * 16 + fr;
            const f32x4 xc = {bflo(xcv[nn][m].x), bfhi(xcv[nn][m].x), bflo(xcv[nn][m].y), bfhi(xcv[nn][m].y)};
            f32x4 av, bvv;
#pragma unroll
            for (int r = 0; r < 4; ++r) { const float rg = sigmoidf_(aR[m][nn][r] + bav[r]), gi = sigmoidf_(aG[m][nn][r] + bxv[r]);
                const float la = 8.0f * rg * lsg[r]; av[r] = __expf(la); bvv[r] = sqrtf(fmaxf(1.0f - av[r] * av[r], 0.f)) * (gi * xc[r]); }
            *(LAS f32x4*)(LA + tl * LAS_STR + cl) = av; *(LAS f32x4*)(LB + tl * LAS_STR + cl) = bvv;
            __builtin_amdgcn_sched_barrier(0); } }
    __syncthreads();
    LAS float* SEGA = LB + 128 * LAS_STR;
    LAS float* SEGH = SEGA + 512;
    const int tid2 = c.wid * 64 + lane_id(); const int ch = tid2 & 127, sg = tid2 >> 7;
    { float A = 1.f, H = 0.f;
#pragma unroll 8
      for (int t = sg * 32; t < sg * 32 + 32; ++t) { const float a = LA[t * LAS_STR + ch], bb = LB[t * LAS_STR + ch]; H = a * H + bb; A *= a; LA[t * LAS_STR + ch] = A; LB[t * LAS_STR + ch] = H; }
      SEGA[sg * 128 + ch] = A; SEGH[sg * 128 + ch] = H; }
    __syncthreads();
    { float Ain = 1.f, Hin = 0.f;
      for (int s2 = 0; s2 < sg; ++s2) { const float a = SEGA[s2 * 128 + ch], hh = SEGH[s2 * 128 + ch]; Hin = a * Hin + hh; Ain *= a; }
      u16* acum = (u16*)(c.ws + WS_ACUM); u16* hloc = (u16*)(c.ws + WS_HLOC);
      float A = 1.f, H = 0.f;
#pragma unroll 8
      for (int t = sg * 32; t < sg * 32 + 32; ++t) { A = LA[t * LAS_STR + ch] * Ain; H = LB[t * LAS_STR + ch] + LA[t * LAS_STR + ch] * Hin;
          acum[(size_t)(t0 + t) * LW + cb + ch] = (u16)(pack2(A, 0.f) & 0xffffu); hloc[(size_t)(t0 + t) * LW + cb + ch] = (u16)(pack2(H, 0.f) & 0xffffu); }
      if (sg == 3) { ((float*)(c.ws + WS_CA))[(b * NCH + n) * LW + cb + ch] = A; ((float*)(c.ws + WS_CH))[(b * NCH + n) * LW + cb + ch] = H; } }
}

DI void lru_fin_unit(const Ctx& c, int u) {
    const int blk = u & 7, n = (u >> 3) & 15, b = u >> 7;
    const int t0 = b * SEQ + n * CHUNK, cb = blk * 128;
    LAS float* hin = (LAS float*)c.lds; const int tid = c.wid * 64 + lane_id();
    __syncthreads();
    if (tid < 128) { const float* ca = (const float*)(c.ws + WS_CA) + (size_t)b * NCH * LW + cb + tid; const float* chh = (const float*)(c.ws + WS_CH) + (size_t)b * NCH * LW + cb + tid;
        float av[NCH - 1], hv[NCH - 1];
#pragma unroll
        for (int m = 0; m < NCH - 1; ++m) { const int mm = m < n ? m : 0; av[m] = ca[mm * LW]; hv[m] = chh[mm * LW]; }
        float hcar = 0.f;
#pragma unroll
        for (int m = 0; m < NCH - 1; ++m) hcar = (m < n) ? av[m] * hcar + hv[m] : hcar;
        hin[tid] = hcar; }
    __syncthreads();
    const u16* acum = (const u16*)(c.ws + WS_ACUM); const u16* hloc = (const u16*)(c.ws + WS_HLOC); const u16* proj = (const u16*)(c.ws + WS_PROJ); u16* mixed = (u16*)(c.ws + WS_MIXED);
#pragma unroll
    for (int it = 0; it < 8; ++it) { const int item = tid + it * NTHR, t = item >> 5, c4 = (item & 31) * 4;
        const size_t o = (size_t)(t0 + t) * LW + cb + c4;
        const u32x2 ar = *(const u32x2*)(acum + o), hr = *(const u32x2*)(hloc + o);
        const f32x4 a = {bflo(ar.x), bfhi(ar.x), bflo(ar.y), bfhi(ar.y)}, hl = {bflo(hr.x), bfhi(hr.x), bflo(hr.y), bfhi(hr.y)}, hi4 = *(const LAS f32x4*)(hin + c4);
        const u32x2 yb = *(const u32x2*)(proj + (size_t)(t0 + t) * INC + 5 * RW + cb + c4);
        const float yg[4] = {bflo(yb.x), bfhi(yb.x), bflo(yb.y), bfhi(yb.y)}; f32x4 ov;
#pragma unroll
        for (int r = 0; r < 4; ++r) ov[r] = gelu_tanh(yg[r]) * (hl[r] + a[r] * hi4[r]);
        *(u32x2*)(mixed + (size_t)(t0 + t) * D + RW + cb + c4) = pack4(ov); }
}

constexpr int XSTR = 4112;
DI void p4_ln_router(const Ctx& c) {
    const KPtr kp = kargs();
    const int lane = lane_id(), w = c.wid, fq = lane >> 4, fr = lane & 15, tid = c.wid * 64 + lane;
    const unsigned base = (unsigned)(size_t)c.lds, Xhi = base, Xlo = base + 16 * XSTR;
    LAS float* red = (LAS float*)c.lds;
    LAS float* logit = (LAS float*)(c.lds + 135168);
    LAS int* sel_e = (LAS int*)(c.lds + 135168 + 4096);
    LAS float* sel_g = (LAS float*)(c.lds + 135168 + 4096 + 512);
    LAS int* sel_p = (LAS int*)(c.lds + 135168 + 4096 + 1024);
    LAS unsigned* lcnt = (LAS unsigned*)(c.lds + 135168 + 4096 + 1536);
    LAS unsigned* gbase = lcnt + 32;
    const u16* y1 = (const u16*)(c.ws + WS_Y1); const float* lw = kp->in[12]; const float* lb = kp->in[13];
    const float* wr_ = kp->in[14]; const float* br_ = kp->in[15];
    u16* x1b = (u16*)(c.ws + WS_X1B); float* st1 = (float*)(c.ws + WS_ST1);
    for (int tb = c.bid; tb < T / 32; tb += c.G) {
    __syncthreads();
    if (tid < 32) lcnt[tid] = 0u;
    const int tokbase = tb * 32;
    for (int pass = 0; pass < 2; ++pass) {
        __syncthreads();
        for (int tt = 0; tt < 2; ++tt) { const int tl = 2 * w + tt, tok = tokbase + pass * 16 + tl;
            const u32x2* src = (const u32x2*)(y1 + (size_t)tok * D); f32x4 v[8]; float s = 0.f;
#pragma unroll
            for (int i = 0; i < 8; ++i) { const u32x2 yv = src[i * 64 + lane]; v[i] = (f32x4){bflo(yv.x), bfhi(yv.x), bflo(yv.y), bfhi(yv.y)}; s += (v[i][0] + v[i][1]) + (v[i][2] + v[i][3]); }
#pragma unroll
            for (int o = 32; o >= 1; o >>= 1) s += __shfl_xor(s, o);
            const float mean = s * (1.0f / D); float qv = 0.f;
#pragma unroll
            for (int i = 0; i < 8; ++i) { const f32x4 dl = v[i] - mean; qv += (dl[0] * dl[0] + dl[1] * dl[1]) + (dl[2] * dl[2] + dl[3] * dl[3]); }
#pragma unroll
            for (int o = 32; o >= 1; o >>= 1) qv += __shfl_xor(qv, o);
            const float rstd = rsqrtf(qv * (1.0f / D) + LN_EPS);
            if (lane == 0) { st1[2 * tok] = mean; st1[2 * tok + 1] = rstd; }
#pragma unroll
            for (int i = 0; i < 8; ++i) { const int d = (i * 64 + lane) * 4; const f32x4 g = *(const f32x4*)(lw + d), bb = *(const f32x4*)(lb + d);
                const f32x4 xv = (v[i] - mean) * rstd * g + bb;
                const u32x2 hi = pack4(xv); const f32x4 rsd = {xv[0] - bflo(hi.x), xv[1] - bfhi(hi.x), xv[2] - bflo(hi.y), xv[3] - bfhi(hi.y)};
                *(u32x2*)(x1b + (size_t)tok * D + d) = hi;
                *LP(u32x2, Xhi + tl * XSTR + d * 2) = hi; *LP(u32x2, Xlo + tl * XSTR + d * 2) = pack4(rsd); } }
        __syncthreads();
        f32x4 acc[2] = {(f32x4){0.f, 0.f, 0.f, 0.f}, (f32x4){0.f, 0.f, 0.f, 0.f}};
#pragma unroll 2
        for (int ks = 0; ks < 8; ++ks) { const int k0 = 256 * w + 32 * ks + 8 * fq;
            const bf16x8 xh = *LP(const bf16x8, Xhi + fr * XSTR + k0 * 2), xl = *LP(const bf16x8, Xlo + fr * XSTR + k0 * 2);
#pragma unroll
            for (int nf = 0; nf < 2; ++nf) {
                float v[8]; const int e = nf * 16 + fr;
#pragma unroll
                for (int j = 0; j < 8; ++j) v[j] = wr_[(size_t)(k0 + j) * NE + e];
                unsigned hw[4], lwv[4];
#pragma unroll
                for (int j = 0; j < 4; ++j) { hw[j] = pack2(v[2 * j], v[2 * j + 1]); lwv[j] = pack2(v[2 * j] - bflo(hw[j]), v[2 * j + 1] - bfhi(hw[j])); }
                const bf16x8 wh = __builtin_bit_cast(bf16x8, (u32x4){hw[0], hw[1], hw[2], hw[3]}), wl = __builtin_bit_cast(bf16x8, (u32x4){lwv[0], lwv[1], lwv[2], lwv[3]});
                acc[nf] = MFMA16(wh, xh, acc[nf]); acc[nf] = MFMA16(wh, xl, acc[nf]); acc[nf] = MFMA16(wl, xh, acc[nf]); } }
        __syncthreads();
#pragma unroll
        for (int nf = 0; nf < 2; ++nf)
#pragma unroll
            for (int r = 0; r < 4; ++r) red[(w * 16 + fr) * 32 + nf * 16 + 4 * fq + r] = acc[nf][r];
        __syncthreads();
        { const int tl = tid >> 5, e = tid & 31; float s = br_[e];
#pragma unroll
          for (int ww = 0; ww < 8; ++ww) s += red[(ww * 16 + tl) * 32 + e];
          logit[(pass * 16 + tl) * 32 + e] = s; }
    }
    __syncthreads();
    if (tid < 32) { float l[32];
#pragma unroll
        for (int e = 0; e < 32; ++e) l[e] = logit[tid * 32 + e];
        float tv[4]; int te[4];
#pragma unroll
        for (int k = 0; k < 4; ++k) { float best = -3.0e38f; int bi = 0;
#pragma unroll
            for (int e = 0; e < 32; ++e) { const bool tk = l[e] > best; best = tk ? l[e] : best; bi = tk ? e : bi; }
            tv[k] = best; te[k] = bi;
#pragma unroll
            for (int e = 0; e < 32; ++e) l[e] = (e == bi) ? -3.0e38f : l[e]; }
        float ex[4], sum = 0.f;
#pragma unroll
        for (int k = 0; k < 4; ++k) { ex[k] = __expf(tv[k] - tv[0]); sum += ex[k]; }
        const float inv = 1.0f / sum;
#pragma unroll
        for (int k = 0; k < 4; ++k) { sel_e[tid * 4 + k] = te[k]; sel_g[tid * 4 + k] = ex[k] * inv; sel_p[tid * 4 + k] = (int)atomicAdd((unsigned*)&lcnt[te[k]], 1u); } }
    __syncthreads();
    { const int t2 = c.wid * 64 + lane_id(); if (t2 < 32) gbase[t2] = lcnt[t2] ? atomicAdd(c.ctl + CW_CNT + 64 * t2, lcnt[t2]) : 0u; }
    __syncthreads();
    { const int t3 = c.wid * 64 + lane_id(); if (t3 < 128) { const int e = sel_e[t3]; const int slot = (int)gbase[e] + sel_p[t3];
        int* lid = (int*)(c.ws + WS_LID); float* lgt = (float*)(c.ws + WS_LGT);
        lid[e * LIST_CAP + slot] = (tokbase + (t3 >> 2)) * 4 + (t3 & 3); lgt[e * LIST_CAP + slot] = sel_g[t3]; } }
    }
}

DI void p7_ln2(const Ctx& c) {
    const KPtr kp = kargs();
    const int lane = lane_id();
    const u16* y1 = (const u16*)(c.ws + WS_Y1); const float* st1 = (const float*)(c.ws + WS_ST1); const u16* yb = (const u16*)(c.ws + WS_YBUF);
    const float* l1w = kp->in[12]; const float* l1b = kp->in[13]; const float* l2w = kp->in[22]; const float* l2b = kp->in[23];
    u16* x2b = (u16*)(c.ws + WS_X2B); const float* ssq = (const float*)(c.ws + WS_SSQ); float* rse = (float*)(c.ws + WS_RSE);
    for (int tb = c.bid; tb < T / 32; tb += c.G)
    for (int tt = 0; tt < 4; ++tt) { const int tok = tb * 32 + c.wid * 4 + tt;
        const float mean1 = st1[2 * tok], rstd1 = st1[2 * tok + 1];
        f32x4 z[8]; float s = 0.f;
#pragma unroll
        for (int i = 0; i < 8; ++i) { const int d = (i * 64 + lane) * 4; const u32x2 yr = *(const u32x2*)(y1 + (size_t)tok * D + d); const f32x4 yv = {bflo(yr.x), bfhi(yr.x), bflo(yr.y), bfhi(yr.y)}, g = *(const f32x4*)(l1w + d), bb = *(const f32x4*)(l1b + d);
            f32x4 a = ((yv - mean1) * rstd1 * g + bb) * DN_ALPHA;
#pragma unroll
            for (int k = 0; k < 4; ++k) { const u32x2 v = *(const u32x2*)(yb + ((size_t)tok * 4 + k) * D + d); a[0] += bflo(v.x); a[1] += bfhi(v.x); a[2] += bflo(v.y); a[3] += bfhi(v.y); }
            z[i] = a; s += (a[0] + a[1]) + (a[2] + a[3]); }
#pragma unroll
        for (int o = 32; o >= 1; o >>= 1) s += __shfl_xor(s, o);
        const float mean = s * (1.0f / D); float qv = 0.f;
#pragma unroll
        for (int i = 0; i < 8; ++i) { const f32x4 dl = z[i] - mean; qv += (dl[0] * dl[0] + dl[1] * dl[1]) + (dl[2] * dl[2] + dl[3] * dl[3]); }
#pragma unroll
        for (int o = 32; o >= 1; o >>= 1) qv += __shfl_xor(qv, o);
        const float rstd = rsqrtf(qv * (1.0f / D) + LN_EPS);
#pragma unroll
        for (int i = 0; i < 8; ++i) { const int d = (i * 64 + lane) * 4; const f32x4 g = *(const f32x4*)(l2w + d), bb = *(const f32x4*)(l2b + d);
            const f32x4 xv = (z[i] - mean) * rstd * g + bb;
            *(u32x2*)(x2b + (size_t)tok * D + d) = pack4(xv); }
        float q2 = (lane < 32) ? ssq[(size_t)tok * 32 + lane] : 0.f;
#pragma unroll
        for (int o = 32; o >= 1; o >>= 1) q2 += __shfl_xor(q2, o);
        if (lane == 0) rse[tok] = rsqrtf(q2 * (1.0f / D) + LN_EPS); }
}

__global__ void __launch_bounds__(NTHR, 2) hybrid_fwd(Params P) {
    extern __shared__ __attribute__((aligned(16))) unsigned char lds_raw[];
    Ctx c; c.lds = (LAS unsigned char*)lds_raw; c.ws = P.ws; c.ctl = (unsigned*)(P.ws + WS_CTL);
    c.wid = __builtin_amdgcn_readfirstlane(threadIdx.x >> 6); c.bid = blockIdx.x; c.G = gridDim.x;
    volatile LAS unsigned* xbw = (volatile LAS unsigned*)(c.lds + LDS_BYTES - 16);
    if (threadIdx.x == 0) { xbw[0] = 0u; xbw[1] = 0u; xbw[2] = 0u; xbw[3] = 0u; }
    __syncthreads();
    const XcdBarrier bar = xcd_barrier_post(c.ctl, xbw);

#ifndef PHMASK
#define PHMASK 0xFFFF
#endif
#define PH(k) if ((PHMASK >> (k)) & 1)
#ifndef DBLMASK
#define DBLMASK 0
#endif
#define DBL(k) if ((DBLMASK >> (k)) & 1)
    PH(0) p0_prologue(c);
    DBL(0) p0_prologue(c);
    xcd_barrier(bar);
    PH(1) p1_gemm(c);
    DBL(1) p1_gemm(c);
    xcd_barrier(bar);
    PH(2) for (int u = c.bid; u < 512; u += c.G) ret_kv_unit(c, u);
    PH(3) for (int u = c.bid; u < 512; u += c.G) lru_local_unit(c, u);
    DBL(2) for (int u = c.bid; u < 512; u += c.G) ret_kv_unit(c, u);
    DBL(3) for (int u = c.bid; u < 512; u += c.G) lru_local_unit(c, u);
    xcd_barrier(bar);
    PH(4) for (int u = c.bid, k = 0; u < 512; u += c.G, ++k) ret_out_unit(c, (c.G == 256 && (k & 1)) ? (u ^ (15 << 3)) : u);
    PH(5) for (int u = c.bid, k = 0; u < 512; u += c.G, ++k) lru_fin_unit(c, (c.G == 256 && (k & 1)) ? (u ^ (15 << 3)) : u);
    DBL(4) for (int u = c.bid; u < 512; u += c.G) ret_out_unit(c, u);
    DBL(5) for (int u = c.bid; u < 512; u += c.G) lru_fin_unit(c, u);
    xcd_barrier(bar);
    PH(6) p3_gemm(c);
    DBL(6) p3_gemm(c);
    xcd_barrier(bar);
    PH(7) p4_ln_router(c);
    xcd_barrier(bar);
    PH(8) p5_moe_up(c);
    DBL(8) p5_moe_up(c);
    xcd_barrier(bar);
    PH(9) p6_moe_down(c);
    DBL(9) p6_moe_down(c);
    xcd_barrier(bar);
    PH(10) p7_ln2(c);
    DBL(10) p7_ln2(c);
    xcd_barrier(bar);
    PH(11) p8_gemm(c);
}
}

extern "C" void kernel_launch(void* const* d_in, const int* in_sizes, int n_in, void* d_out, int out_size, void* d_ws, size_t ws_size, hipStream_t stream) {
    static int grid = 0;
    if (grid == 0) {
        int dev = 0, cus = 0, per_cu = 0;
        if (n_in != 27 || ws_size < WS_END) { grid = -1; return; }
        if (hipGetDevice(&dev) != hipSuccess || hipDeviceGetAttribute(&cus, hipDeviceAttributeMultiprocessorCount, dev) != hipSuccess) { grid = -1; return; }
        if (hipFuncSetAttribute((const void*)hybrid_fwd, hipFuncAttributeMaxDynamicSharedMemorySize, LDS_BYTES) != hipSuccess) { grid = -1; return; }
        (void)hipOccupancyMaxActiveBlocksPerMultiprocessor(&per_cu, (const void*)hybrid_fwd, NTHR, LDS_BYTES);
        (void)hipGetLastError();
        if (per_cu < 1) { grid = -1; return; }
        grid = (cus / 8) * 8;
        if (grid > 256) grid = 256;
    }
    if (grid <= 0) return;
    (void)in_sizes; (void)out_size;
    (void)hipMemsetAsync((char*)d_ws + WS_CTL, 0, CTL_BYTES, stream);
    Params p{};
    for (int i = 0; i < 27; ++i) p.in[i] = (const float*)d_in[i];
    p.out = (float*)d_out; p.ws = (unsigned char*)d_ws;
    hipLaunchKernelGGL(hybrid_fwd, dim3(grid), dim3(NTHR), LDS_BYTES, stream, p);
}
```

```cpp
#include <hip/hip_runtime.h>
#include <stdint.h>

namespace {
#define LAS __attribute__((address_space(3)))
#define DI __device__ __forceinline__
typedef short bf16x8 __attribute__((ext_vector_type(8)));
typedef short s16x4 __attribute__((ext_vector_type(4)));
typedef float f32x4 __attribute__((ext_vector_type(4)));
typedef float f32x2 __attribute__((ext_vector_type(2)));
typedef __bf16 bf16x4_t __attribute__((ext_vector_type(4)));
typedef __bf16 bf16x2_t __attribute__((ext_vector_type(2)));
typedef unsigned u32x4 __attribute__((ext_vector_type(4)));
typedef unsigned u32x2 __attribute__((ext_vector_type(2)));
typedef unsigned short u16;

constexpr int T = 8192, D = 2048, SEQ = 2048, INC = 6144, RW = 1024, LW = 1024;
constexpr int NE = 32, PLE = 256, CHUNK = 128, NCH = 16, NHEAD = 8;
constexpr float LN_EPS = 1e-5f;
constexpr float DN_ALPHA = 1.189207115002721f;
constexpr int NTHR = 512;
constexpr int LDS_BYTES = 147456;
constexpr int LIST_CAP = 8192;

constexpr size_t WS_CTL   = 0;
constexpr size_t CTL_BYTES = 32768;
constexpr size_t WS_XB    = 65536;
constexpr size_t WS_PB    = WS_XB    + (size_t)T * D * 2;
constexpr size_t WS_ROPE  = WS_PB    + (size_t)T * PLE * 2;
constexpr size_t WS_PROJ  = WS_ROPE  + (size_t)SEQ * 64 * 2 * 4;
constexpr size_t WS_EP    = WS_PROJ  + (size_t)T * INC * 2;
constexpr size_t WS_SSQ   = WS_EP    + (size_t)T * D * 2;
constexpr size_t WS_KV    = WS_SSQ   + (size_t)T * 32 * 4;
constexpr size_t WS_ACUM  = WS_KV    + (size_t)512 * 128 * 128 * 4;
constexpr size_t WS_HLOC  = WS_ACUM  + (size_t)T * LW * 4;
constexpr size_t WS_CA    = WS_HLOC  + (size_t)T * LW * 4;
constexpr size_t WS_CH    = WS_CA    + (size_t)4 * 16 * 1024 * 4;
constexpr size_t WS_MIXED = WS_CH    + (size_t)4 * 16 * 1024 * 4;
constexpr size_t WS_Y1    = WS_MIXED + (size_t)T * D * 2;
constexpr size_t WS_X1B   = WS_Y1    + (size_t)T * D * 4;
constexpr size_t WS_ST1   = WS_X1B   + (size_t)T * D * 2;
constexpr size_t WS_LID   = WS_ST1   + (size_t)T * 2 * 4;
constexpr size_t WS_LGT   = WS_LID   + (size_t)NE * LIST_CAP * 4;
constexpr size_t WS_HID   = WS_LGT   + (size_t)NE * LIST_CAP * 4;
constexpr size_t WS_YBUF  = WS_HID   + (size_t)41984 * 2048 * 2;
constexpr size_t WS_X2B   = WS_YBUF  + (size_t)32768 * 2048 * 2;
constexpr size_t WS_RSE   = WS_X2B   + (size_t)T * D * 2;
constexpr size_t WS_END   = WS_RSE   + (size_t)T * 4;

constexpr int CW_CNT = 4096;

#define XB_TMO      128
#define XB_XCNT(j)  (256  + 64 * (j))
#define XB_XSUB(j)  (1280 + 64 * (j))
#define XB_XGEN(j)  (2304 + 64 * (j))
#define XB_TOP      3328
#define XB_TOPGEN   3392
#define XCD_BAR_WORDS 3456
#define XB_SPIN_CAP (1u << 18)

DI unsigned xb_ld(unsigned* p)              { return __hip_atomic_load(p, __ATOMIC_RELAXED, __HIP_MEMORY_SCOPE_AGENT); }
DI unsigned xb_add(unsigned* p, unsigned v) { return __hip_atomic_fetch_add(p, v, __ATOMIC_RELAXED, __HIP_MEMORY_SCOPE_AGENT); }
DI unsigned xb_xcc_id() { return (unsigned)__builtin_amdgcn_s_getreg((3 << 11) | 20) & 0xFu; }
#define XB_SPIN(cond, bar) do { unsigned _sp = 0; while (cond) { __builtin_amdgcn_s_sleep(1); \
    if ((++_sp & 255u) == 0u) { if (xb_ld(&(bar)[XB_TMO])) break; if (_sp > XB_SPIN_CAP) { atomicAdd(&(bar)[XB_TMO], 1u); break; } } } } while (0)

struct XcdBarrier { unsigned* bar; unsigned x; volatile LAS unsigned* st; };

DI XcdBarrier xcd_barrier_post(unsigned* bar, volatile LAS unsigned* st) {
    XcdBarrier b; b.bar = bar; b.x = xb_xcc_id(); b.st = st;
    if (threadIdx.x == 0) (void)xb_add(&bar[XB_XCNT(b.x)], 1u);
    return b;
}
DI void xcd_barrier_complete(unsigned* bar, unsigned x, unsigned& nloc, unsigned& nx) {
    const unsigned G = gridDim.x * gridDim.y * gridDim.z;
    unsigned sum, cnt, mine, sp = 0u;
    for (;;) {
        sum = 0u; cnt = 0u; mine = 0u;
#pragma unroll
        for (unsigned j = 0; j < 16; ++j) { const unsigned c = xb_ld(&bar[XB_XCNT(j)]); sum += c; cnt += (c > 0u) ? 1u : 0u; mine = (j == x) ? c : mine; }
        if (sum == G) break;
        __builtin_amdgcn_s_sleep(1);
        if ((++sp & 255u) == 0u) { if (xb_ld(&bar[XB_TMO])) break; if (sp > XB_SPIN_CAP) { atomicAdd(&bar[XB_TMO], 1u); break; } }
    }
    nloc = mine > 0u ? mine : 1u; nx = cnt > 0u ? cnt : 1u;
}
DI void xcd_barrier(const XcdBarrier& b) {
    asm volatile("s_waitcnt vmcnt(0)" ::: "memory");
    __syncthreads();
    if (threadIdx.x == 0) {
        unsigned* bar = b.bar;
        __builtin_amdgcn_s_waitcnt(0);
        unsigned nloc = b.st[0], nx = b.st[1];
        if (nloc == 0u) { xcd_barrier_complete(bar, b.x, nloc, nx); b.st[0] = nloc; b.st[1] = nx; }
        const unsigned old = xb_add(&bar[XB_XSUB(b.x)], 1u);
        const unsigned gen = old / nloc;
        if (old + 1u == (gen + 1u) * nloc) {
            __builtin_amdgcn_fence(__ATOMIC_RELEASE, "agent");
            asm volatile("s_waitcnt vmcnt(0)" ::: "memory");
            const unsigned og = xb_add(&bar[XB_TOP], 1u);
            const unsigned tg = og / nx;
            if (og + 1u == (tg + 1u) * nx) xb_add(&bar[XB_TOPGEN], 1u);
            else XB_SPIN(xb_ld(&bar[XB_TOPGEN]) == tg, bar);
            __builtin_amdgcn_fence(__ATOMIC_ACQUIRE, "agent");
            xb_add(&bar[XB_XGEN(b.x)], 1u);
            asm volatile("s_waitcnt vmcnt(0)" ::: "memory");
        } else {
            XB_SPIN(xb_ld(&bar[XB_XGEN(b.x)]) == gen, bar);
            __builtin_amdgcn_fence(__ATOMIC_ACQUIRE, "agent");
            asm volatile("s_waitcnt vmcnt(0)" ::: "memory");
        }
    }
    __syncthreads();
}

DI float bf2f(u16 v) { return __uint_as_float(((unsigned)v) << 16); }
DI float bflo(unsigned w) { return __uint_as_float(w << 16); }
DI float bfhi(unsigned w) { return __uint_as_float(w & 0xffff0000u); }
DI unsigned pack2(float a, float b) { f32x2 v = {a, b}; bf16x2_t r = __builtin_convertvector(v, bf16x2_t); return __builtin_bit_cast(unsigned, r); }
DI u32x2 pack4(f32x4 v) { bf16x4_t r = __builtin_convertvector(v, bf16x4_t); return __builtin_bit_cast(u32x2, r); }
DI float sigmoidf_(float x) { return __builtin_amdgcn_rcpf(1.0f + __expf(-x)); }
DI float gelu_tanh(float x) { const float u = 0.7978845608028654f * (x + 0.044715f * x * x * x); const float e = __expf(2.0f * u); const float th = 1.0f - 2.0f / (e + 1.0f); return 0.5f * x * (1.0f + th); }
#define LP(type, addr) ((LAS type*)(uintptr_t)(addr))
DI s16x4 tr_read(unsigned byte_addr) { return __builtin_amdgcn_ds_read_tr16_b64_v4i16(LP(s16x4, byte_addr)); }
DI s16x4 tr_read_na(LAS s16x4* __restrict__ p) { return __builtin_amdgcn_ds_read_tr16_b64_v4i16(p); }
DI bf16x8 cat8(s16x4 lo, s16x4 hi) { return __builtin_shufflevector(lo, hi, 0, 1, 2, 3, 4, 5, 6, 7); }
#define MFMA16(a, b, c) __builtin_amdgcn_mfma_f32_16x16x32_bf16((a), (b), (c), 0, 0, 0)
DI int trrow(int k) { return k ^ ((k >> 1) & 4); }

DI int lane_id() { int l; asm volatile("v_mbcnt_lo_u32_b32 %0, -1, 0\n\tv_mbcnt_hi_u32_b32 %0, -1, %0" : "=v"(l)); return l; }

struct Params {
    const float* in[27];
    float* out;
    unsigned char* ws;
};
typedef const __attribute__((address_space(4))) Params* KPtr;
DI KPtr kargs() { KPtr p = (KPtr)__builtin_amdgcn_kernarg_segment_ptr(); asm volatile("" : "+s"(p)); return p; }

constexpr int G_BSTRIDE = 544, G_BBUF = 64 * G_BSTRIDE, G_B0 = 0, G_B1 = G_BBUF, G_AREG = 0;
#define OPAQUE_LDS(p) asm volatile("" : "+v"(p))
typedef int i32x4 __attribute__((ext_vector_type(4)));
DI __amdgpu_buffer_rsrc_t mk_rsrc(const void* p) { return __builtin_amdgcn_make_buffer_rsrc((void*)p, 0, 0x7FFFFFF0, 0x00020000); }
DI u32x4 bload16(__amdgpu_buffer_rsrc_t r, unsigned voff, unsigned soff) { return __builtin_bit_cast(u32x4, __builtin_amdgcn_raw_buffer_load_b128(r, (int)voff, (int)soff, 0)); }

template <bool GU, class U, class S, int MF = 8>
DI void gemm_stream(LAS unsigned char* lds, const int wid, int nt, const int ldb, const S& sched) {
    constexpr int ABUF = MF * 4096, G_A0 = 0, G_A1 = ABUF, G_BREG = 2 * ABUF, NG = 2 * MF;
    asm volatile("" : "+s"(nt));
    const int lane = lane_id(), wr = wid >> 2, wc = wid & 3, fr = lane & 15, fq = lane >> 4;
    U cur;
    if (!sched.get(0, cur)) return;
    __amdgpu_buffer_rsrc_t rsB0, rsB1, rsA; unsigned voa0, voa1, voa2, voa3, voa4 = 0;
#define G_SETUP_B(u) do { rsB0 = mk_rsrc((u).b0); rsB1 = mk_rsrc((u).b1); } while (0)
#define G_SETUP_A(u) do { \
        const int _l = lane_id(), sb_ = _l * 16, swz = sb_ ^ (((sb_ >> 9) & 1) << 5); \
        const int R0 = (wid >> 1) * 16 + (swz >> 6), C0 = (wid & 1) * 32 + ((swz & 63) >> 1); \
        rsA = mk_rsrc((u).al.base()); \
        voa0 = (u).al.rowoff(R0) + C0 * 2; voa1 = (u).al.rowoff(R0 + 64) + C0 * 2; voa2 = (u).al.rowoff(R0 + 128) + C0 * 2; voa3 = (u).al.rowoff(R0 + 192) + C0 * 2; \
        if (MF == 9) voa4 = (u).al.rowoff(256 + ((wid >> 1) & 1) * 16 + (swz >> 6)) + C0 * 2;        \
        } while (0)
#define G_SETUP(u) do { G_SETUP_B(u); G_SETUP_A(u); } while (0)
    G_SETUP(cur);
    const int hl = lane >> 5, sc = (lane & 31) * 4;
    const unsigned vob = (unsigned)((2 * wid + hl) * ldb + sc) * 4u;
    const unsigned kstepB = (unsigned)ldb * 64u;
    const int pos0 = (GU ? (sc >> 5) * 64 : (sc & ~31)) + ((sc >> 2) & 1) * 16 + ((sc >> 3) & 3) * 4;
    LAS unsigned char* b_wr = lds + G_BREG + (((2 * wid + hl) ^ (wid & 4)) * G_BSTRIDE) + pos0 * 2; OPAQUE_LDS(b_wr);
    constexpr int SLAB1 = GU ? 64 : 256;
    LAS unsigned char* a_rd = lds + G_AREG + wr * (MF * 2048) + ((fr * 64 + fq * 16) ^ (((fr >> 3) & 1) << 5)); OPAQUE_LDS(a_rd);
    const int q = (lane & 15) >> 2, p = lane & 3;
    LAS unsigned char* b_rd0 = lds + G_BREG + fq * (8 * G_BSTRIDE) + (((fq & 1) * 4 + q) * G_BSTRIDE) + wc * 128 + p * 8; OPAQUE_LDS(b_rd0);
    LAS unsigned char* b_rd1 = lds + G_BREG + fq * (8 * G_BSTRIDE) + ((((fq & 1) ^ 1) * 4 + q) * G_BSTRIDE) + wc * 128 + p * 8; OPAQUE_LDS(b_rd1);

    f32x4 acc[MF][4];
    u32x4 sb[8];
    LAS unsigned char* a_dma = lds + G_AREG + wid * 1024;

#define G_DMA_A(kt, AO) do { G_DMA1(kt, AO, 0); G_DMA1(kt, AO, 1); G_DMA1(kt, AO, 2); G_DMA1(kt, AO, 3); if (MF == 9) G_DMA5(kt, AO); } while (0)
#define G_ISSUE_B(kt) do { const unsigned _sb = (unsigned)(kt) * 4u * kstepB; \
        _Pragma("unroll") for (int _i = 0; _i < 8; ++_i) sb[_i] = bload16(_i < 4 ? rsB0 : rsB1, vob, _sb + (_i & 3) * kstepB); } while (0)
#define G_WRITE_B(BO) do { \
        _Pragma("unroll") for (int _i = 0; _i < 8; ++_i) *(LAS u32x2*)(b_wr + (BO) + (_i & 3) * (16 * G_BSTRIDE) + (_i >> 2) * SLAB1) = pack4(__builtin_bit_cast(f32x4, sb[_i])); } while (0)
#define G_DMA1(kt, AO, pc) __builtin_amdgcn_raw_ptr_buffer_load_lds(rsA, (LAS void*)(a_dma + (AO) + (pc) * 8192), 16, (int)((pc) == 0 ? voa0 : (pc) == 1 ? voa1 : (pc) == 2 ? voa2 : voa3), (int)((unsigned)(kt) * 128u), 0, 0)
#define G_DMA5(kt, AO) __builtin_amdgcn_raw_ptr_buffer_load_lds(rsA, (LAS void*)(lds + G_AREG + (AO) + 32768 + (wid & 3) * 1024), 16, (int)voa4, (int)((unsigned)(kt) * 128u), 0, 0)
#define G_WR1(BO, i) (*(LAS u32x2*)(b_wr + (BO) + ((i) & 3) * (16 * G_BSTRIDE) + ((i) >> 2) * SLAB1) = pack4(__builtin_bit_cast(f32x4, sb[i])))
#define G_LD1(kt, i) (sb[i] = bload16(((i) < 4) ? rsB0 : rsB1, vob, (unsigned)(kt) * 4u * kstepB + (unsigned)((i) & 3) * kstepB))
#define G_RD_A(AO, ks, m) (*(const LAS bf16x8*)(a_rd + (AO) + (m) * 2048 + (ks) * 1024))
#define G_TR(BO, ks, n) cat8(tr_read_na((LAS s16x4*)(b_rd0 + (BO) + (ks) * (32 * G_BSTRIDE) + (n) * 32)), \
                             tr_read_na((LAS s16x4*)(b_rd1 + (BO) + (ks) * (32 * G_BSTRIDE) + (n) * 32)))
#define G_TILE(AR, BR, DO_MEM, BW, AW, kA, HAS_B, kB, HOOK) do { \
        bf16x8 Bf[4], Af[3]; \
        _Pragma("unroll") for (int n = 0; n < 4; ++n) Bf[n] = G_TR(BR, 0, n); \
        Af[0] = G_RD_A(AR, 0, 0); Af[1] = G_RD_A(AR, 0, 1); \
        _Pragma("unroll") for (int g = 0; g < NG; ++g) { const int m = g % MF; \
            if (g < NG - 2) Af[(g + 2) % 3] = G_RD_A(AR, (g + 2) / MF, (g + 2) % MF); \
            if (DO_MEM && g == 0) { G_DMA1(kA, AW, 0); G_DMA1(kA, AW, 1); G_DMA1(kA, AW, 2); G_DMA1(kA, AW, 3); if (MF == 9) G_DMA5(kA, AW); HOOK; } \
            _Pragma("unroll") for (int n = 0; n < 4; ++n) { acc[m][n] = MFMA16(Bf[n], Af[g % 3], acc[m][n]); \
                if (g == MF - 1) Bf[n] = G_TR(BR, 1, n); }            \
            if (DO_MEM && (g & 1) && g < 16) { G_WR1(BW, g >> 1); __builtin_amdgcn_sched_barrier(0); if (HAS_B) G_LD1(kB, g >> 1); } \
            __builtin_amdgcn_sched_barrier(0); } \
    } while (0)
#define G_ENDTILE(VM) do { asm volatile("s_waitcnt vmcnt(" #VM ")" ::: "memory"); \
        asm volatile("s_waitcnt lgkmcnt(0)" ::: "memory"); __builtin_amdgcn_s_barrier(); asm volatile("" ::: "memory"); } while (0)

    __builtin_amdgcn_s_barrier();
    G_DMA_A(0, G_A0); G_ISSUE_B(0); G_WRITE_B(G_B0);
    __builtin_amdgcn_sched_barrier(0);
    G_ISSUE_B(1);
    __builtin_amdgcn_sched_barrier(0);
    G_ENDTILE(8);
    for (int ui = 0;; ++ui) {
#pragma unroll
        for (int m = 0; m < MF; ++m)
#pragma unroll
            for (int n = 0; n < 4; ++n) acc[m][n] = (f32x4){0.f, 0.f, 0.f, 0.f};
        for (int t = 0; t < nt - 2; t += 2) {
            G_TILE(G_A0, G_B0, true, G_B1, G_A1, t + 1, true, t + 2, (void)0);
            G_ENDTILE(8);
            G_TILE(G_A1, G_B1, true, G_B0, G_A0, t + 2, true, t + 3, (void)0);
            G_ENDTILE(8);
        }
        U nxt = cur;
        const bool has_next = sched.get(ui + 1, nxt);
        G_SETUP_B(nxt);
        G_TILE(G_A0, G_B0, true, G_B1, G_A1, nt - 1, true, 0, G_SETUP_A(nxt));
        G_ENDTILE(8);
        G_TILE(G_A1, G_B1, true, G_B0, G_A0, 0, true, 1, (void)0);
        G_ENDTILE(8);
        { const int l2 = lane_id(); cur.ep(acc, wr, wc, l2 & 15, l2 >> 4); }
        if (!has_next) break;
        cur = nxt;
    }
    asm volatile("s_waitcnt vmcnt(0)" ::: "memory");
#undef G_SETUP_A
#undef G_SETUP_B
#undef G_SETUP
#undef G_DMA_A
#undef G_ISSUE_B
#undef G_WRITE_B
#undef G_DMA1
#undef G_DMA5
#undef G_WR1
#undef G_LD1
#undef G_RD_A
#undef G_TR
#undef G_TILE
#undef G_ENDTILE
}

struct ARows { const u16* b; int lda; DI const void* base() const { return b; } DI unsigned rowoff(int r) const { return (unsigned)(r * lda) * 2u; } };
struct AGather { const u16* x; const int* ids; int m0, cnt; DI const void* base() const { return x; }
    DI unsigned rowoff(int r) const { int i = m0 + r; i = i < cnt ? i : cnt - 1;
        const unsigned v = (unsigned)__builtin_amdgcn_raw_buffer_load_b32(__builtin_amdgcn_make_buffer_rsrc((void*)ids, 0, 0x7FFFFFF0, 0x00020000), i * 4, 0, 0);
        return (v >> 2) * (unsigned)(D * 2); } };

struct Ctx {
    LAS unsigned char* lds; unsigned char* ws; unsigned* ctl; int wid, bid, G;
};

DI void p0_prologue(const Ctx& c) {
    const KPtr kp = kargs();
    const int tid = c.wid * 64 + lane_id();
    const size_t gt = (size_t)c.bid * NTHR + tid, gs = (size_t)c.G * NTHR;
    { const f32x4* src = (const f32x4*)kp->in[0]; u32x4* dst = (u32x4*)(c.ws + WS_XB);
      for (size_t i = gt; i < (size_t)T * D / 8; i += gs) { const f32x4 a = src[2 * i], b = src[2 * i + 1]; const u32x2 lo = pack4(a), hi = pack4(b); dst[i] = (u32x4){lo.x, lo.y, hi.x, hi.y}; } }
    { const f32x4* src = (const f32x4*)kp->in[1]; u32x4* dst = (u32x4*)(c.ws + WS_PB);
      for (size_t i = gt; i < (size_t)T * PLE / 8; i += gs) { const f32x4 a = src[2 * i], b = src[2 * i + 1]; const u32x2 lo = pack4(a), hi = pack4(b); dst[i] = (u32x4){lo.x, lo.y, hi.x, hi.y}; } }
    { f32x2* rope = (f32x2*)(c.ws + WS_ROPE);
      for (size_t i = gt; i < (size_t)SEQ * 64; i += gs) { const int pos = (int)(i >> 6), k = (int)(i & 63);
        const float inv = exp2f(-(float)k * (13.287712379549449f / 64.0f));
        const float ang = (float)pos * inv;
        double rv = (double)ang * 0.15915494309189535; rv -= floor(rv);
        const float f = (float)rv;
        rope[i] = (f32x2){__builtin_amdgcn_cosf(f), __builtin_amdgcn_sinf(f)}; } }
}

struct EpiProj { u16* out; int row0, col0;
    DI void operator()(const f32x4 (&acc)[8][4], int wr, int wc, int fr, int fq) const {
#pragma unroll
        for (int m = 0; m < 8; ++m) { u16* rp = out + (size_t)(row0 + wr * 128 + m * 16 + fr) * INC + col0 + wc * 64 + 8 * fq;
#pragma unroll
            for (int h = 0; h < 2; ++h) { const u32x2 lo = pack4(acc[m][2 * h]), hi = pack4(acc[m][2 * h + 1]); *(u32x4*)(rp + h * 32) = (u32x4){lo.x, lo.y, hi.x, hi.y}; } }
    } };
struct EpiPle { u16* out; float* ssq; int row0, ntile;
    DI void operator()(const f32x4 (&acc)[8][4], int wr, int wc, int fr, int fq) const {
#pragma unroll
        for (int m = 0; m < 8; ++m) { const int row = row0 + wr * 128 + m * 16 + fr; u16* rp = out + (size_t)row * D + ntile * 256 + wc * 64 + 8 * fq; float s = 0.f;
#pragma unroll
            for (int n = 0; n < 4; ++n) { const f32x4 v = acc[m][n]; s += (v[0] * v[0] + v[1] * v[1]) + (v[2] * v[2] + v[3] * v[3]); }
#pragma unroll
            for (int h = 0; h < 2; ++h) { const u32x2 lo = pack4(acc[m][2 * h]), hi = pack4(acc[m][2 * h + 1]); *(u32x4*)(rp + h * 32) = (u32x4){lo.x, lo.y, hi.x, hi.y}; }
            s += __shfl_xor(s, 16); s += __shfl_xor(s, 32);
            if (fq == 0) ssq[(size_t)row * 32 + ntile * 4 + wc] = s; }
    } };
struct EpiY1 { const u16* x; u16* y; int row0, col0;
    DI void operator()(const f32x4 (&acc)[8][4], int wr, int wc, int fr, int fq) const {
#pragma unroll
        for (int m = 0; m < 8; ++m) { const size_t off = (size_t)(row0 + wr * 128 + m * 16 + fr) * D + col0 + wc * 64 + 8 * fq;
#pragma unroll
            for (int h = 0; h < 2; ++h) { const u32x4 xr = *(const u32x4*)(x + off + h * 32);
                const f32x4 x0 = {bflo(xr.x), bfhi(xr.x), bflo(xr.y), bfhi(xr.y)}, x1 = {bflo(xr.z), bfhi(xr.z), bflo(xr.w), bfhi(xr.w)};
                const u32x2 lo = pack4(x0 * DN_ALPHA + acc[m][2 * h]), hi = pack4(x1 * DN_ALPHA + acc[m][2 * h + 1]); *(u32x4*)(y + off + h * 32) = (u32x4){lo.x, lo.y, hi.x, hi.y}; } }
    } };
struct EpiHid { u16* hid; const float* bg; const float* bu; int row0, hc0;
    template <int MF> DI void operator()(const f32x4 (&acc)[MF][4], int wr, int wc, int fr, int fq) const {
        const int hc = hc0 + wc * 32 + 8 * fq;
        f32x4 bgv[2], buv[2];
#pragma unroll
        for (int n = 0; n < 2; ++n) { bgv[n] = *(const f32x4*)(bg + hc + 4 * n); buv[n] = *(const f32x4*)(bu + hc + 4 * n); }
#pragma unroll
        for (int m = 0; m < MF; ++m) { u16* rp = hid + (size_t)(row0 + wr * (16 * MF) + m * 16 + fr) * D + hc; u32x2 w[2];
#pragma unroll
            for (int n = 0; n < 2; ++n) { f32x4 g = acc[m][n] + bgv[n], u = acc[m][n + 2] + buv[n], h;
#pragma unroll
                for (int j = 0; j < 4; ++j) { const float gt = fminf(g[j], 7.0f); const float up = fminf(fmaxf(u[j], -7.0f), 7.0f); h[j] = (up + 1.0f) * gt * sigmoidf_(1.702f * gt); }
                w[n] = pack4(h); }
            *(u32x4*)rp = (u32x4){w[0].x, w[0].y, w[1].x, w[1].y}; }
    } };
struct EpiDown { u16* ybuf; const float* bd; const int* ids; const float* gts; int m0, cnt, col0;
    template <int MF> DI void operator()(const f32x4 (&acc)[MF][4], int wr, int wc, int fr, int fq) const {
        f32x4 bv[4];
#pragma unroll
        for (int n = 0; n < 4; ++n) bv[n] = *(const f32x4*)(bd + col0 + wc * 64 + 32 * (n >> 1) + 8 * fq + 4 * (n & 1));
#pragma unroll
        for (int m = 0; m < MF; ++m) { const int i = m0 + wr * (16 * MF) + m * 16 + fr;
            if (i < cnt) { const int id = ids[i]; const float g = gts[i]; u16* rp = ybuf + (size_t)id * D + col0 + wc * 64 + 8 * fq;
#pragma unroll
                for (int h = 0; h < 2; ++h) { const u32x2 lo = pack4((acc[m][2 * h] + bv[2 * h]) * g), hi = pack4((acc[m][2 * h + 1] + bv[2 * h + 1]) * g);
                    *(u32x4*)(rp + h * 32) = (u32x4){lo.x, lo.y, hi.x, hi.y}; } } }
    } };
struct EpiOut { float* out; const u16* x2b; const u16* ep; const float* rse; const float* pnw; int row0, col0;
    DI void operator()(const f32x4 (&acc)[8][4], int wr, int wc, int fr, int fq) const {
        f32x4 wv[4];
#pragma unroll
        for (int n = 0; n < 4; ++n) wv[n] = *(const f32x4*)(pnw + col0 + wc * 64 + 32 * (n >> 1) + 8 * fq + 4 * (n & 1));
#pragma unroll
        for (int m = 0; m < 8; ++m) { const int row = row0 + wr * 128 + m * 16 + fr; const float rs = rse[row]; const size_t off = (size_t)row * D + col0 + wc * 64 + 8 * fq;
#pragma unroll
            for (int h = 0; h < 2; ++h) { const u32x4 xr = *(const u32x4*)(x2b + off + h * 32), er = *(const u32x4*)(ep + off + h * 32);
                const unsigned xw[4] = {xr.x, xr.y, xr.z, xr.w}, ew[4] = {er.x, er.y, er.z, er.w};
#pragma unroll
                for (int q = 0; q < 2; ++q) { const f32x4 a = acc[m][2 * h + q]; const f32x4 w4 = wv[2 * h + q]; f32x4 o;
                    o[0] = bflo(xw[2 * q]) + sigmoidf_(a[0]) * bflo(ew[2 * q]) * rs * w4[0]; o[1] = bfhi(xw[2 * q]) + sigmoidf_(a[1]) * bfhi(ew[2 * q]) * rs * w4[1];
                    o[2] = bflo(xw[2 * q + 1]) + sigmoidf_(a[2]) * bflo(ew[2 * q + 1]) * rs * w4[2]; o[3] = bfhi(xw[2 * q + 1]) + sigmoidf_(a[3]) * bfhi(ew[2 * q + 1]) * rs * w4[3];
                    *(f32x4*)(out + off + h * 32 + 4 * q) = o; } } }
    } };

DI bool deal_tiles(int bid, int G, int nM, int nN, int i, int& pm, int& pn) {
    const int x = bid & 7, r = bid >> 3, W = G >> 3;
    const int mper = nM >> 3;
    const int q = i * W + r;
    if (q >= mper * nN) return false;
    pm = x * mper + (q % mper); pn = q / mper; return true;
}

template <class EP> struct UnitD { ARows al; const float* b0; const float* b1; EP ep; DI int rows() const { return 256; } };
struct SchedProj { int bid, G; const u16* xb; const float* w; u16* proj;
    DI bool get(int i, UnitD<EpiProj>& u) const { int pm, pn; if (!deal_tiles(bid, G, T / 256, INC / 256, i, pm, pn)) return false;
        u.al = ARows{xb + (size_t)pm * 256 * D, D}; u.b0 = w + pn * 256; u.b1 = u.b0 + 128; u.ep = EpiProj{proj, pm * 256, pn * 256}; return true; } };
struct SchedPle { int bid, G; const u16* pb; const float* w; u16* epo; float* ssq;
    DI bool get(int i, UnitD<EpiPle>& u) const { int pm, pn; if (!deal_tiles(bid, G, T / 256, D / 256, i, pm, pn)) return false;
        u.al = ARows{pb + (size_t)pm * 256 * PLE, PLE}; u.b0 = w + pn * 256; u.b1 = u.b0 + 128; u.ep = EpiPle{epo, ssq, pm * 256, pn}; return true; } };
struct SchedY1 { int bid, G; const u16* mx; const float* w; const u16* x; u16* y;
    DI bool get(int i, UnitD<EpiY1>& u) const { int pm, pn; if (!deal_tiles(bid, G, T / 256, D / 256, i, pm, pn)) return false;
        u.al = ARows{mx + (size_t)pm * 256 * D, D}; u.b0 = w + pn * 256; u.b1 = u.b0 + 128; u.ep = EpiY1{x, y, pm * 256, pn * 256}; return true; } };
struct SchedOut { int bid, G; const u16* xb; const float* w; float* out; const u16* epi; const float* rse; const float* pnw;
    DI bool get(int i, UnitD<EpiOut>& u) const { int pm, pn; if (!deal_tiles(bid, G, T / 256, D / 256, i, pm, pn)) return false;
        u.al = ARows{xb + (size_t)pm * 256 * D, D}; u.b0 = w + pn * 256; u.b1 = u.b0 + 128; u.ep = EpiOut{out, xb, epi, rse, pnw, pm * 256, pn * 256}; return true; } };

DI void p1_gemm(const Ctx& c) {
    const KPtr kp = kargs();
    { const SchedProj S{c.bid, c.G, (const u16*)(c.ws + WS_XB), kp->in[2], (u16*)(c.ws + WS_PROJ)};
      gemm_stream<false, UnitD<EpiProj>>(c.lds, c.wid, D / 64, INC, S); }
    { const SchedPle S{c.bid, c.G, (const u16*)(c.ws + WS_PB), kp->in[24], (u16*)(c.ws + WS_EP), (float*)(c.ws + WS_SSQ)};
      gemm_stream<false, UnitD<EpiPle>>(c.lds, c.wid, PLE / 64, D, S); }
}
DI void p3_gemm(const Ctx& c) {
    const KPtr kp = kargs();
    const SchedY1 S{c.bid, c.G, (const u16*)(c.ws + WS_MIXED), kp->in[11], (const u16*)(c.ws + WS_XB), (u16*)(c.ws + WS_Y1)};
    gemm_stream<false, UnitD<EpiY1>>(c.lds, c.wid, D / 64, D, S);
}
DI void p8_gemm(const Ctx& c) {
    const KPtr kp = kargs();
    const SchedOut S{c.bid, c.G, (const u16*)(c.ws + WS_X2B), kp->in[26], kp->out, (const u16*)(c.ws + WS_EP), (const float*)(c.ws + WS_RSE), kp->in[25]};
    gemm_stream<false, UnitD<EpiOut>>(c.lds, c.wid, D / 64, D, S);
}

constexpr int MOE_MF = 9, MOE_BM = 32 * MOE_MF;
constexpr int MS_OFF = 143424;
template <bool ALL>
DI void moe_build_sched(const Ctx& c) {
    LAS int* S = (LAS int*)(c.lds + MS_OFF);
    __syncthreads();
    if (c.wid == 0) {
        const int lane = lane_id(), x = c.bid & 7;
        const int myc = (lane < NE) ? (int)c.ctl[CW_CNT + 64 * lane] : 0;
        int load[8] = {0, 0, 0, 0, 0, 0, 0, 0}; int hb = 0, nown = 0;
#pragma unroll
        for (int e = 0; e < NE; ++e) { const int cn = __builtin_amdgcn_readlane(myc, e), mc = (cn + MOE_BM - 1) / MOE_BM;
            int best = 0, bl = load[0];
#pragma unroll
            for (int j = 1; j < 8; ++j) { const bool lt = load[j] < bl; bl = lt ? load[j] : bl; best = lt ? j : best; }
#pragma unroll
            for (int j = 0; j < 8; ++j) load[j] += (j == best) ? mc : 0;
            if ((ALL || best == x) && mc > 0) { if (lane == 0) { S[8 + 4 * nown] = e; S[9 + 4 * nown] = mc; S[10 + 4 * nown] = cn; S[11 + 4 * nown] = hb; } ++nown; }
            hb += mc * MOE_BM; }
        if (lane == 0) S[0] = nown;
    }
    __syncthreads();
}
DI bool moe_find(const Ctx& c, int qi, int NT, int& e, int& nt, int& mt, int& cn, int& hb) {
    LAS int* S = (LAS int*)(c.lds + MS_OFF);
    const int nown = __builtin_amdgcn_readfirstlane(S[0]); int accu = 0;
    for (int k = 0; k < nown; ++k) { const int mc = __builtin_amdgcn_readfirstlane(S[9 + 4 * k]);
        if (qi < accu + NT * mc) { const int loc = qi - accu; nt = loc / mc; mt = loc - nt * mc;
            e = __builtin_amdgcn_readfirstlane(S[8 + 4 * k]); cn = __builtin_amdgcn_readfirstlane(S[10 + 4 * k]); hb = __builtin_amdgcn_readfirstlane(S[11 + 4 * k]); return true; }
        accu += NT * mc; }
    return false;
}
struct UnitUp { AGather al; const float* b0; const float* b1; EpiHid ep; int nrows; DI int rows() const { return nrows; } };
struct SchedUp { const Ctx& c; int r, W; const u16* x1b; const int* lid; const float* wg; const float* wu; const float* bg; const float* bu; u16* hid;
    DI bool get(int i, UnitUp& u) const { int e, nt, mt, cn, hb; if (!moe_find(c, r + i * W, 2, e, nt, mt, cn, hb)) return false; nt = (c.bid & 7) + 8 * nt;
        u.al = AGather{x1b, lid + e * LIST_CAP, mt * MOE_BM, cn}; u.b0 = wg + (size_t)e * D * D + nt * 128; u.b1 = wu + (size_t)e * D * D + nt * 128;
        u.ep = EpiHid{hid, bg + e * D, bu + e * D, hb + mt * MOE_BM, nt * 128}; u.nrows = cn - mt * MOE_BM; return true; } };
struct UnitDown { ARows al; const float* b0; const float* b1; EpiDown ep; int nrows; DI int rows() const { return nrows; } };
struct SchedDown { const Ctx& c; int r, W; const u16* hid; const int* lid; const float* lgt; const float* wd; const float* bd; u16* ybuf;
    DI bool get(int i, UnitDown& u) const { int e, nt, mt, cn, hb; if (!moe_find(c, r + i * W, 8, e, nt, mt, cn, hb)) return false;
        u.al = ARows{hid + (size_t)(hb + mt * MOE_BM) * D, D}; u.b0 = wd + (size_t)e * D * D + nt * 256; u.b1 = u.b0 + 128;
        u.ep = EpiDown{ybuf, bd + e * D, lid + e * LIST_CAP, lgt + e * LIST_CAP, mt * MOE_BM, cn, nt * 256}; u.nrows = cn - mt * MOE_BM; return true; } };
DI void p5_moe_up(const Ctx& c) {
    const KPtr kp = kargs();
    moe_build_sched<true>(c);
    const SchedUp S{c, c.bid >> 3, c.G >> 3, (const u16*)(c.ws + WS_X1B), (const int*)(c.ws + WS_LID), kp->in[16], kp->in[18], kp->in[17], kp->in[19], (u16*)(c.ws + WS_HID)};
    gemm_stream<true, UnitUp, SchedUp, MOE_MF>(c.lds, c.wid, D / 64, D, S);
}
DI void p6_moe_down(const Ctx& c) {
    const KPtr kp = kargs();
    moe_build_sched<false>(c);
    const SchedDown S{c, c.bid >> 3, c.G >> 3, (const u16*)(c.ws + WS_HID), (const int*)(c.ws + WS_LID), (const float*)(c.ws + WS_LGT), kp->in[20], kp->in[21], (u16*)(c.ws + WS_YBUF)};
    gemm_stream<false, UnitDown, SchedDown, MOE_MF>(c.lds, c.wid, D / 64, D, S);
}

DI float head_log_gamma(int h) { return log1pf(-exp2f(-5.0f - (float)h)); }

template <bool TRIMG>
DI void stage_rope(const Ctx& c, unsigned dst, int stride, int t0, int col0, int pos0, float scale, float lg, bool kdec) {
    const u16* proj = (const u16*)(c.ws + WS_PROJ); const f32x2* rope = (const f32x2*)(c.ws + WS_ROPE); const int tid = c.wid * 64 + lane_id();
#pragma unroll
    for (int it = 0; it < 2; ++it) { const int item = tid + it * NTHR, j = item >> 3, pc = item & 7, dd = pc * 8;
        const u16* rp = proj + (size_t)(t0 + j) * INC + col0 + dd;
        const u32x4 a = *(const u32x4*)rp, b = *(const u32x4*)(rp + 64);
        const f32x4* cs = (const f32x4*)(rope + (size_t)(pos0 + j) * 64 + dd);
        const f32x4 c0 = cs[0], c1 = cs[1], c2 = cs[2], c3 = cs[3];
        const float sc = kdec ? scale * __expf((float)(127 - j) * lg) : scale;
        float x1[8] = {bflo(a.x), bfhi(a.x), bflo(a.y), bfhi(a.y), bflo(a.z), bfhi(a.z), bflo(a.w), bfhi(a.w)};
        float x2[8] = {bflo(b.x), bfhi(b.x), bflo(b.y), bfhi(b.y), bflo(b.z), bfhi(b.z), bflo(b.w), bfhi(b.w)};
        const float cc[8] = {c0[0], c0[2], c1[0], c1[2], c2[0], c2[2], c3[0], c3[2]};
        const float ss[8] = {c0[1], c0[3], c1[1], c1[3], c2[1], c2[3], c3[1], c3[3]};
        float o1[8], o2[8];
#pragma unroll
        for (int k = 0; k < 8; ++k) { o1[k] = (x1[k] * cc[k] - x2[k] * ss[k]) * sc; o2[k] = (x1[k] * ss[k] + x2[k] * cc[k]) * sc; }
        const int row = TRIMG ? trrow(j) : j;
        *LP(u32x4, dst + row * stride + dd * 2) = (u32x4){pack2(o1[0], o1[1]), pack2(o1[2], o1[3]), pack2(o1[4], o1[5]), pack2(o1[6], o1[7])};
        *LP(u32x4, dst + row * stride + (64 + dd) * 2) = (u32x4){pack2(o2[0], o2[1]), pack2(o2[2], o2[3]), pack2(o2[4], o2[5]), pack2(o2[6], o2[7])}; }
}
template <bool TRIMG>
DI void stage_plain(const Ctx& c, unsigned dst, int stride, int t0, int col0) {
    const u16* proj = (const u16*)(c.ws + WS_PROJ); const int tid = c.wid * 64 + lane_id();
#pragma unroll
    for (int it = 0; it < 4; ++it) { const int item = tid + it * NTHR, j = item >> 4, ch = item & 15;
        const u32x4 a = *(const u32x4*)(proj + (size_t)(t0 + j) * INC + col0 + ch * 8);
        const int row = TRIMG ? trrow(j) : j;
        *LP(u32x4, dst + row * stride + ch * 16) = a; }
}
DI bf16x8 tr_frag(unsigned img, int stride, int k0, int n0, int lane) {
    const int fq = lane >> 4, q = (lane & 15) >> 2, p = lane & 3;
    const int kb = k0 + 8 * fq, par = (kb >> 3) & 1;
    const unsigned a0 = img + (kb + ((par * 4) + q)) * stride + n0 * 2 + p * 8;
    const unsigned a1 = img + (kb + (((par ^ 1) * 4) + q)) * stride + n0 * 2 + p * 8;
    return cat8(tr_read(a0), tr_read(a1));
}
DI bf16x8 row_frag(unsigned img, int stride, int r0, int k0, int lane) {
    return *LP(const bf16x8, img + (r0 + (lane & 15)) * stride + (k0 + 8 * (lane >> 4)) * 2);
}

constexpr int RS = 272, TS = 288;
constexpr int IMG_R = 128 * RS, IMG_T = 128 * TS;

DI void ret_kv_unit(const Ctx& c, int u) {
    const int h = u & 7, n = (u >> 3) & 15, b = u >> 7;
    const int t0 = b * SEQ + n * CHUNK; const float lg = head_log_gamma(h);
    const unsigned base = (unsigned)(size_t)c.lds, Kimg = base, Vimg = base + IMG_T;
    __syncthreads();
    stage_rope<true>(c, Kimg, TS, t0, RW + h * 128, n * CHUNK, 0.08838834764831845f, lg, true);
    stage_plain<true>(c, Vimg, TS, t0, 2 * RW + h * 128);
    __syncthreads();
    f32x4 acc[8];
#pragma unroll
    for (int i = 0; i < 8; ++i) acc[i] = (f32x4){0.f, 0.f, 0.f, 0.f};
    const int d0 = c.wid * 16, lane = lane_id();
#pragma unroll
    for (int ks = 0; ks < 4; ++ks) { const bf16x8 kf = tr_frag(Kimg, TS, ks * 32, d0, lane);
#pragma unroll
        for (int ef = 0; ef < 8; ++ef) acc[ef] = MFMA16(tr_frag(Vimg, TS, ks * 32, ef * 16, lane), kf, acc[ef]); }
    u16* kv = (u16*)(c.ws + WS_KV) + (size_t)((b * NHEAD + h) * NCH + n) * 16384;
    const int d = d0 + (lane & 15), fq = lane >> 4;
#pragma unroll
    for (int ef = 0; ef < 8; ++ef) *(u32x2*)(kv + d * 128 + ef * 16 + 4 * fq) = pack4(acc[ef]);
}

DI void ret_out_unit(const Ctx& c, int u) {
    const KPtr kp = kargs();
    const int h = u & 7, n = (u >> 3) & 15, b = u >> 7;
    const int t0 = b * SEQ + n * CHUNK; const float lg = head_log_gamma(h);
    const unsigned base = (unsigned)(size_t)c.lds, Qimg = base, Kimg = base + IMG_R, Vimg = base + 2 * IMG_R, Simg = base + 2 * IMG_R + IMG_T;
    const u16* proj = (const u16*)(c.ws + WS_PROJ);
    __syncthreads();
    stage_rope<false>(c, Qimg, RS, t0, h * 128, n * CHUNK, 1.0f, lg, false);
    stage_rope<false>(c, Kimg, RS, t0, RW + h * 128, n * CHUNK, 0.08838834764831845f, lg, false);
    stage_plain<true>(c, Vimg, TS, t0, 2 * RW + h * 128);
    {
        const float cd = __expf(128.0f * lg);
        const u16* kv = (const u16*)(c.ws + WS_KV) + (size_t)((b * NHEAD + h) * NCH) * 16384; const int tid = c.wid * 64 + lane_id();
        f32x4 s[8];
#pragma unroll
        for (int i = 0; i < 8; ++i) s[i] = (f32x4){0.f, 0.f, 0.f, 0.f};
#pragma unroll 4
        for (int m = 0; m < n; ++m) { const u32x2* src = (const u32x2*)(kv + (size_t)m * 16384);
#pragma unroll
            for (int i = 0; i < 8; ++i) { const u32x2 v = src[tid + i * NTHR]; s[i] = s[i] * cd + (f32x4){bflo(v.x), bfhi(v.x), bflo(v.y), bfhi(v.y)}; } }
#pragma unroll
        for (int i = 0; i < 8; ++i) { const int idx = tid + i * NTHR, dd = idx >> 5, e4 = (idx & 31) * 4;
            *LP(u32x2, Simg + trrow(dd) * TS + e4 * 2) = pack4(s[i]); }
    }
    __syncthreads();
    const int w = c.wid, lane = lane_id(), fq = lane >> 4, il = 16 * w + (lane & 15);
    bf16x8 qf[4];
#pragma unroll
    for (int ks = 0; ks < 4; ++ks) qf[ks] = row_frag(Qimg, RS, 16 * w, ks * 32, lane);
    f32x4 acc[8];
#pragma unroll
    for (int i = 0; i < 8; ++i) acc[i] = (f32x4){0.f, 0.f, 0.f, 0.f};
#pragma unroll
    for (int ks = 0; ks < 4; ++ks)
#pragma unroll
        for (int ef = 0; ef < 8; ++ef) acc[ef] = MFMA16(tr_frag(Simg, TS, ks * 32, ef * 16, lane), qf[ks], acc[ef]);
    { const float qd = __expf((float)(il + 1) * lg);
#pragma unroll
      for (int ef = 0; ef < 8; ++ef) acc[ef] *= qd; }
    f32x4 sc[8];
#pragma unroll
    for (int jf = 0; jf < 8; ++jf) { sc[jf] = (f32x4){0.f, 0.f, 0.f, 0.f};
        if (jf <= w) {
#pragma unroll
            for (int ks = 0; ks < 4; ++ks) sc[jf] = MFMA16(row_frag(Kimg, RS, jf * 16, ks * 32, lane), qf[ks], sc[jf]);
#pragma unroll
            for (int r = 0; r < 4; ++r) { const int j = jf * 16 + 4 * fq + r; sc[jf][r] = (il >= j) ? sc[jf][r] * __expf((float)(il - j) * lg) : 0.f; }
        } }
    __syncthreads();
    const unsigned Pimg = Kimg;
#pragma unroll
    for (int jf = 0; jf < 8; ++jf) *LP(u32x2, Pimg + il * RS + (jf * 16 + 4 * fq) * 2) = pack4(sc[jf]);
    __syncthreads();
#pragma unroll
    for (int ks = 0; ks < 4; ++ks) if (ks <= (w >> 1)) { const bf16x8 pf = row_frag(Pimg, RS, 16 * w, ks * 32, lane);
#pragma unroll
        for (int ef = 0; ef < 8; ++ef) acc[ef] = MFMA16(tr_frag(Vimg, TS, ks * 32, ef * 16, lane), pf, acc[ef]); }
    float s = 0.f;
#pragma unroll
    for (int ef = 0; ef < 8; ++ef) s += (acc[ef][0] + acc[ef][1]) + (acc[ef][2] + acc[ef][3]);
    s += __shfl_xor(s, 16); s += __shfl_xor(s, 32);
    const float mean = s * (1.0f / 128.0f); float qv = 0.f;
#pragma unroll
    for (int ef = 0; ef < 8; ++ef) { const f32x4 dlt = acc[ef] - mean; qv += (dlt[0] * dlt[0] + dlt[1] * dlt[1]) + (dlt[2] * dlt[2] + dlt[3] * dlt[3]); }
    qv += __shfl_xor(qv, 16); qv += __shfl_xor(qv, 32);
    const float rstd = rsqrtf(qv * (1.0f / 128.0f) + LN_EPS);
    const float* gnw = kp->in[3] + h * 128; u16* mixed = (u16*)(c.ws + WS_MIXED);
    const size_t trow = (size_t)(t0 + il);
#pragma unroll
    for (int ef = 0; ef < 8; ++ef) { const int e = ef * 16 + 4 * fq; const f32x4 gw = *(const f32x4*)(gnw + e);
        const u32x2 gb = *(const u32x2*)(proj + trow * INC + 3 * RW + h * 128 + e);
        const float g[4] = {bflo(gb.x), bfhi(gb.x), bflo(gb.y), bfhi(gb.y)}; f32x4 o;
#pragma unroll
        for (int r = 0; r < 4; ++r) o[r] = (acc[ef][r] - mean) * rstd * gw[r] * (g[r] * sigmoidf_(g[r]));
        *(u32x2*)(mixed + trow * D + h * 128 + e) = pack4(o); }
}

constexpr int LAS_STR = 132;
DI void lru_local_unit(const Ctx& c, int u) {
    const KPtr kp = kargs();
    const int blk = u & 7, n = (u >> 3) & 15, b = u >> 7;
    const int t0 = b * SEQ + n * CHUNK, cb = blk * 128;
    const unsigned base = (unsigned)(size_t)c.lds, Aimg = base, Waimg = base + IMG_R, Wximg = base + IMG_R + IMG_T;
    const u16* proj = (const u16*)(c.ws + WS_PROJ);
    const float* conv_w = kp->in[4]; const float* conv_b = kp->in[5];
    __syncthreads();
    {
        const float* wa = kp->in[6] + (size_t)blk * 16384; const float* wx = kp->in[8] + (size_t)blk * 16384;
        const int tid = c.wid * 64 + lane_id();
#pragma unroll
        for (int it = 0; it < 8; ++it) { const int item = tid + it * NTHR, i = item >> 5, jc = item & 31;
            *LP(u32x2, Waimg + trrow(i) * TS + jc * 8) = pack4(*(const f32x4*)(wa + i * 128 + jc * 4));
            *LP(u32x2, Wximg + trrow(i) * TS + jc * 8) = pack4(*(const f32x4*)(wx + i * 128 + jc * 4)); }
    }
    {
        const int tid = c.wid * 64 + lane_id(); const int tr = tid >> 4, cc = tid & 15, ch = cb + cc * 8;
        float xin[7][8];
#pragma unroll
        for (int rr = 0; rr < 7; ++rr) { const int tl = 4 * tr - 3 + rr;
            if (n == 0 && tl < 0) {
#pragma unroll
                for (int k = 0; k < 8; ++k) xin[rr][k] = 0.f;
            } else { const u32x4 v = *(const u32x4*)(proj + (size_t)(t0 + tl) * INC + 4 * RW + ch);
                xin[rr][0] = bflo(v.x); xin[rr][1] = bfhi(v.x); xin[rr][2] = bflo(v.y); xin[rr][3] = bfhi(v.y); xin[rr][4] = bflo(v.z); xin[rr][5] = bfhi(v.z); xin[rr][6] = bflo(v.w); xin[rr][7] = bfhi(v.w); } }
        float wv[4][8], bv[8];
#pragma unroll
        for (int j = 0; j < 4; ++j) { const f32x4 w0 = *(const f32x4*)(conv_w + j * LW + ch), w1 = *(const f32x4*)(conv_w + j * LW + ch + 4);
            wv[j][0] = w0[0]; wv[j][1] = w0[1]; wv[j][2] = w0[2]; wv[j][3] = w0[3]; wv[j][4] = w1[0]; wv[j][5] = w1[1]; wv[j][6] = w1[2]; wv[j][7] = w1[3]; }
        { const f32x4 b0 = *(const f32x4*)(conv_b + ch), b1 = *(const f32x4*)(conv_b + ch + 4); bv[0] = b0[0]; bv[1] = b0[1]; bv[2] = b0[2]; bv[3] = b0[3]; bv[4] = b1[0]; bv[5] = b1[1]; bv[6] = b1[2]; bv[7] = b1[3]; }
#pragma unroll
        for (int r = 0; r < 4; ++r) { float o[8];
#pragma unroll
            for (int k = 0; k < 8; ++k) o[k] = bv[k] + wv[0][k] * xin[r][k] + wv[1][k] * xin[r + 1][k] + wv[2][k] * xin[r + 2][k] + wv[3][k] * xin[r + 3][k];
            *LP(u32x4, Aimg + (4 * tr + r) * RS + cc * 16) = (u32x4){pack2(o[0], o[1]), pack2(o[2], o[3]), pack2(o[4], o[5]), pack2(o[6], o[7])}; }
    }
    __syncthreads();
    const int wr = c.wid >> 2, wc = c.wid & 3; int lane = lane_id(); int fr = lane & 15, fq = lane >> 4;
    f32x4 aR[4][2], aG[4][2];
    f32x4 bavv[2], bxvv[2], lmvv[2];
#pragma unroll
    for (int nn = 0; nn < 2; ++nn) { const int cl0 = cb + wc * 32 + nn * 16 + 4 * fq;
        bavv[nn] = *(const f32x4*)(kp->in[7] + cl0); bxvv[nn] = *(const f32x4*)(kp->in[9] + cl0); lmvv[nn] = *(const f32x4*)(kp->in[10] + cl0); }
#pragma unroll
    for (int m = 0; m < 4; ++m)
#pragma unroll
        for (int nn = 0; nn < 2; ++nn) { aR[m][nn] = (f32x4){0.f, 0.f, 0.f, 0.f}; aG[m][nn] = (f32x4){0.f, 0.f, 0.f, 0.f}; }
#pragma unroll
    for (int ks = 0; ks < 4; ++ks) { bf16x8 xf[4];
#pragma unroll
        for (int m = 0; m < 4; ++m) xf[m] = row_frag(Aimg, RS, wr * 64 + m * 16, ks * 32, lane);
#pragma unroll
        for (int nn = 0; nn < 2; ++nn) { const bf16x8 fa = tr_frag(Waimg, TS, ks * 32, wc * 32 + nn * 16, lane), fx = tr_frag(Wximg, TS, ks * 32, wc * 32 + nn * 16, lane);
#pragma unroll
            for (int m = 0; m < 4; ++m) { aR[m][nn] = MFMA16(fa, xf[m], aR[m][nn]); aG[m][nn] = MFMA16(fx, xf[m], aG[m][nn]); } } }
    u32x2 xcv[2][4];
#pragma unroll
    for (int nn = 0; nn < 2; ++nn)
#pragma unroll
        for (int m = 0; m < 4; ++m) xcv[nn][m] = *LP(const u32x2, Aimg + (wr * 64 + m * 16 + fr) * RS + (wc * 32 + nn * 16 + 4 * fq) * 2);
    __syncthreads();
    lane = lane_id(); fr = lane & 15; fq = lane >> 4;
    LAS float* LA = (LAS float*)c.lds; LAS float* LB = LA + 128 * LAS_STR;
#pragma unroll
    for (int nn = 0; nn < 2; ++nn) { const int cl = wc * 32 + nn * 16 + 4 * fq;
        const f32x4 bav = bavv[nn], bxv = bxvv[nn], lmv = lmvv[nn];
        f32x4 lsg;
#pragma unroll
        for (int r = 0; r < 4; ++r) lsg[r] = -log1pf(__expf(-lmv[r]));
#pragma unroll
        for (int m = 0; m < 4; ++m) { const int tl = wr * 64 + m * 16 + fr;
            const f32x4 xc = {bflo(xcv[nn][m].x), bfhi(xcv[nn][m].x), bflo(xcv[nn][m].y), bfhi(xcv[nn][m].y)};
            f32x4 av, bvv;
#pragma unroll
            for (int r = 0; r < 4; ++r) { const float rg = sigmoidf_(aR[m][nn][r] + bav[r]), gi = sigmoidf_(aG[m][nn][r] + bxv[r]);
                const float la = 8.0f * rg * lsg[r]; av[r] = __expf(la); bvv[r] = __builtin_amdgcn_sqrtf(fmaxf(1.0f - av[r] * av[r], 0.f)) * (gi * xc[r]); }
            *(LAS f32x4*)(LA + tl * LAS_STR + cl) = av; *(LAS f32x4*)(LB + tl * LAS_STR + cl) = bvv; } }
    __syncthreads();
    LAS float* SEGA = LB + 128 * LAS_STR;
    LAS float* SEGH = SEGA + 512;
    const int tid2 = c.wid * 64 + lane_id(); const int ch = tid2 & 127, sg = tid2 >> 7;
    { float A = 1.f, H = 0.f;
#pragma unroll 8
      for (int t = sg * 32; t < sg * 32 + 32; ++t) { const float a = LA[t * LAS_STR + ch], bb = LB[t * LAS_STR + ch]; H = a * H + bb; A *= a; LA[t * LAS_STR + ch] = A; LB[t * LAS_STR + ch] = H; }
      SEGA[sg * 128 + ch] = A; SEGH[sg * 128 + ch] = H; }
    __syncthreads();
    { float Ain = 1.f, Hin = 0.f;
      for (int s2 = 0; s2 < sg; ++s2) { const float a = SEGA[s2 * 128 + ch], hh = SEGH[s2 * 128 + ch]; Hin = a * Hin + hh; Ain *= a; }
      float A = 1.f, H = 0.f;
#pragma unroll 8
      for (int t = sg * 32; t < sg * 32 + 32; ++t) { const float la = LA[t * LAS_STR + ch]; A = la * Ain; H = LB[t * LAS_STR + ch] + la * Hin;
          LA[t * LAS_STR + ch] = A; LB[t * LAS_STR + ch] = H; }
      if (sg == 3) { ((float*)(c.ws + WS_CA))[(b * NCH + n) * LW + cb + ch] = A; ((float*)(c.ws + WS_CH))[(b * NCH + n) * LW + cb + ch] = H; } }
    __syncthreads();
    { u16* acum = (u16*)(c.ws + WS_ACUM); u16* hloc = (u16*)(c.ws + WS_HLOC);
#pragma unroll
      for (int it = 0; it < 4; ++it) { const int item = tid2 + it * NTHR, t = item >> 4, c8 = (item & 15) * 8;
          const f32x4 a0 = *(const LAS f32x4*)(LA + t * LAS_STR + c8), a1 = *(const LAS f32x4*)(LA + t * LAS_STR + c8 + 4);
          const f32x4 h0 = *(const LAS f32x4*)(LB + t * LAS_STR + c8), h1 = *(const LAS f32x4*)(LB + t * LAS_STR + c8 + 4);
          const u32x2 al = pack4(a0), ah = pack4(a1), hl = pack4(h0), hh = pack4(h1);
          *(u32x4*)(acum + (size_t)(t0 + t) * LW + cb + c8) = (u32x4){al.x, al.y, ah.x, ah.y};
          *(u32x4*)(hloc + (size_t)(t0 + t) * LW + cb + c8) = (u32x4){hl.x, hl.y, hh.x, hh.y}; } }
}

DI void lru_fin_unit(const Ctx& c, int u) {
    const int blk = u & 7, n = (u >> 3) & 15, b = u >> 7;
    const int t0 = b * SEQ + n * CHUNK, cb = blk * 128;
    LAS float* hin = (LAS float*)c.lds; const int tid = c.wid * 64 + lane_id();
    __syncthreads();
    if (tid < 128) { const float* ca = (const float*)(c.ws + WS_CA) + (size_t)b * NCH * LW + cb + tid; const float* chh = (const float*)(c.ws + WS_CH) + (size_t)b * NCH * LW + cb + tid;
        float av[NCH - 1], hv[NCH - 1];
#pragma unroll
        for (int m = 0; m < NCH - 1; ++m) { const int mm = m < n ? m : 0; av[m] = ca[mm * LW]; hv[m] = chh[mm * LW]; }
        float hcar = 0.f;
#pragma unroll
        for (int m = 0; m < NCH - 1; ++m) hcar = (m < n) ? av[m] * hcar + hv[m] : hcar;
        hin[tid] = hcar; }
    __syncthreads();
    const u16* acum = (const u16*)(c.ws + WS_ACUM); const u16* hloc = (const u16*)(c.ws + WS_HLOC); const u16* proj = (const u16*)(c.ws + WS_PROJ); u16* mixed = (u16*)(c.ws + WS_MIXED);
#pragma unroll
    for (int it = 0; it < 8; ++it) { const int item = tid + it * NTHR, t = item >> 5, c4 = (item & 31) * 4;
        const size_t o = (size_t)(t0 + t) * LW + cb + c4;
        const u32x2 ar = *(const u32x2*)(acum + o), hr = *(const u32x2*)(hloc + o);
        const f32x4 a = {bflo(ar.x), bfhi(ar.x), bflo(ar.y), bfhi(ar.y)}, hl = {bflo(hr.x), bfhi(hr.x), bflo(hr.y), bfhi(hr.y)}, hi4 = *(const LAS f32x4*)(hin + c4);
        const u32x2 yb = *(const u32x2*)(proj + (size_t)(t0 + t) * INC + 5 * RW + cb + c4);
        const float yg[4] = {bflo(yb.x), bfhi(yb.x), bflo(yb.y), bfhi(yb.y)}; f32x4 ov;
#pragma unroll
        for (int r = 0; r < 4; ++r) ov[r] = gelu_tanh(yg[r]) * (hl[r] + a[r] * hi4[r]);
        *(u32x2*)(mixed + (size_t)(t0 + t) * D + RW + cb + c4) = pack4(ov); }
}

constexpr int XSTR = 4112;
DI void p4_ln_router(const Ctx& c) {
    const KPtr kp = kargs();
    const int lane = lane_id(), w = c.wid, fq = lane >> 4, fr = lane & 15, tid = c.wid * 64 + lane;
    const unsigned base = (unsigned)(size_t)c.lds, Xhi = base, Xlo = base + 16 * XSTR;
    LAS float* red = (LAS float*)c.lds;
    LAS float* logit = (LAS float*)(c.lds + 135168);
    LAS int* sel_e = (LAS int*)(c.lds + 135168 + 4096);
    LAS float* sel_g = (LAS float*)(c.lds + 135168 + 4096 + 512);
    LAS int* sel_p = (LAS int*)(c.lds + 135168 + 4096 + 1024);
    LAS unsigned* lcnt = (LAS unsigned*)(c.lds + 135168 + 4096 + 1536);
    LAS unsigned* gbase = lcnt + 32;
    const u16* y1 = (const u16*)(c.ws + WS_Y1); const float* lw = kp->in[12]; const float* lb = kp->in[13];
    const float* wr_ = kp->in[14]; const float* br_ = kp->in[15];
    u16* x1b = (u16*)(c.ws + WS_X1B); float* st1 = (float*)(c.ws + WS_ST1);
    for (int tb = c.bid; tb < T / 32; tb += c.G) {
    __syncthreads();
    if (tid < 32) lcnt[tid] = 0u;
    const int tokbase = tb * 32;
    for (int pass = 0; pass < 2; ++pass) {
        __syncthreads();
        for (int tt = 0; tt < 2; ++tt) { const int tl = 2 * w + tt, tok = tokbase + pass * 16 + tl;
            const u32x2* src = (const u32x2*)(y1 + (size_t)tok * D); f32x4 v[8]; float s = 0.f;
#pragma unroll
            for (int i = 0; i < 8; ++i) { const u32x2 yv = src[i * 64 + lane]; v[i] = (f32x4){bflo(yv.x), bfhi(yv.x), bflo(yv.y), bfhi(yv.y)}; s += (v[i][0] + v[i][1]) + (v[i][2] + v[i][3]); }
#pragma unroll
            for (int o = 32; o >= 1; o >>= 1) s += __shfl_xor(s, o);
            const float mean = s * (1.0f / D); float qv = 0.f;
#pragma unroll
            for (int i = 0; i < 8; ++i) { const f32x4 dl = v[i] - mean; qv += (dl[0] * dl[0] + dl[1] * dl[1]) + (dl[2] * dl[2] + dl[3] * dl[3]); }
#pragma unroll
            for (int o = 32; o >= 1; o >>= 1) qv += __shfl_xor(qv, o);
            const float rstd = rsqrtf(qv * (1.0f / D) + LN_EPS);
            if (lane == 0) { st1[2 * tok] = mean; st1[2 * tok + 1] = rstd; }
#pragma unroll
            for (int i = 0; i < 8; ++i) { const int d = (i * 64 + lane) * 4; const f32x4 g = *(const f32x4*)(lw + d), bb = *(const f32x4*)(lb + d);
                const f32x4 xv = (v[i] - mean) * rstd * g + bb;
                const u32x2 hi = pack4(xv); const f32x4 rsd = {xv[0] - bflo(hi.x), xv[1] - bfhi(hi.x), xv[2] - bflo(hi.y), xv[3] - bfhi(hi.y)};
                *(u32x2*)(x1b + (size_t)tok * D + d) = hi;
                *LP(u32x2, Xhi + tl * XSTR + d * 2) = hi; *LP(u32x2, Xlo + tl * XSTR + d * 2) = pack4(rsd); } }
        __syncthreads();
        f32x4 acc[2] = {(f32x4){0.f, 0.f, 0.f, 0.f}, (f32x4){0.f, 0.f, 0.f, 0.f}};
#pragma unroll 2
        for (int ks = 0; ks < 8; ++ks) { const int k0 = 256 * w + 32 * ks + 8 * fq;
            const bf16x8 xh = *LP(const bf16x8, Xhi + fr * XSTR + k0 * 2), xl = *LP(const bf16x8, Xlo + fr * XSTR + k0 * 2);
#pragma unroll
            for (int nf = 0; nf < 2; ++nf) {
                float v[8]; const int e = nf * 16 + fr;
#pragma unroll
                for (int j = 0; j < 8; ++j) v[j] = wr_[(size_t)(k0 + j) * NE + e];
                unsigned hw[4], lwv[4];
#pragma unroll
                for (int j = 0; j < 4; ++j) { hw[j] = pack2(v[2 * j], v[2 * j + 1]); lwv[j] = pack2(v[2 * j] - bflo(hw[j]), v[2 * j + 1] - bfhi(hw[j])); }
                const bf16x8 wh = __builtin_bit_cast(bf16x8, (u32x4){hw[0], hw[1], hw[2], hw[3]}), wl = __builtin_bit_cast(bf16x8, (u32x4){lwv[0], lwv[1], lwv[2], lwv[3]});
                acc[nf] = MFMA16(wh, xh, acc[nf]); acc[nf] = MFMA16(wh, xl, acc[nf]); acc[nf] = MFMA16(wl, xh, acc[nf]); } }
        __syncthreads();
#pragma unroll
        for (int nf = 0; nf < 2; ++nf)
#pragma unroll
            for (int r = 0; r < 4; ++r) red[(w * 16 + fr) * 32 + nf * 16 + 4 * fq + r] = acc[nf][r];
        __syncthreads();
        { const int tl = tid >> 5, e = tid & 31; float s = br_[e];
#pragma unroll
          for (int ww = 0; ww < 8; ++ww) s += red[(ww * 16 + tl) * 32 + e];
          logit[(pass * 16 + tl) * 32 + e] = s; }
    }
    __syncthreads();
    if (tid < 32) { float l[32];
#pragma unroll
        for (int e = 0; e < 32; ++e) l[e] = logit[tid * 32 + e];
        float tv[4]; int te[4];
#pragma unroll
        for (int k = 0; k < 4; ++k) { float best = -3.0e38f; int bi = 0;
#pragma unroll
            for (int e = 0; e < 32; ++e) { const bool tk = l[e] > best; best = tk ? l[e] : best; bi = tk ? e : bi; }
            tv[k] = best; te[k] = bi;
#pragma unroll
            for (int e = 0; e < 32; ++e) l[e] = (e == bi) ? -3.0e38f : l[e]; }
        float ex[4], sum = 0.f;
#pragma unroll
        for (int k = 0; k < 4; ++k) { ex[k] = __expf(tv[k] - tv[0]); sum += ex[k]; }
        const float inv = 1.0f / sum;
#pragma unroll
        for (int k = 0; k < 4; ++k) { sel_e[tid * 4 + k] = te[k]; sel_g[tid * 4 + k] = ex[k] * inv; sel_p[tid * 4 + k] = (int)atomicAdd((unsigned*)&lcnt[te[k]], 1u); } }
    __syncthreads();
    { const int t2 = c.wid * 64 + lane_id(); if (t2 < 32) gbase[t2] = lcnt[t2] ? atomicAdd(c.ctl + CW_CNT + 64 * t2, lcnt[t2]) : 0u; }
    __syncthreads();
    { const int t3 = c.wid * 64 + lane_id(); if (t3 < 128) { const int e = sel_e[t3]; const int slot = (int)gbase[e] + sel_p[t3];
        int* lid = (int*)(c.ws + WS_LID); float* lgt = (float*)(c.ws + WS_LGT);
        lid[e * LIST_CAP + slot] = (tokbase + (t3 >> 2)) * 4 + (t3 & 3); lgt[e * LIST_CAP + slot] = sel_g[t3]; } }
    }
}

DI void p7_ln2(const Ctx& c) {
    const KPtr kp = kargs();
    const int lane = lane_id();
    const u16* y1 = (const u16*)(c.ws + WS_Y1); const float* st1 = (const float*)(c.ws + WS_ST1); const u16* yb = (const u16*)(c.ws + WS_YBUF);
    const float* l1w = kp->in[12]; const float* l1b = kp->in[13]; const float* l2w = kp->in[22]; const float* l2b = kp->in[23];
    u16* x2b = (u16*)(c.ws + WS_X2B); const float* ssq = (const float*)(c.ws + WS_SSQ); float* rse = (float*)(c.ws + WS_RSE);
    for (int tb = c.bid; tb < T / 32; tb += c.G)
    for (int tt = 0; tt < 4; ++tt) { const int tok = tb * 32 + c.wid * 4 + tt;
        const float mean1 = st1[2 * tok], rstd1 = st1[2 * tok + 1];
        f32x4 z[8]; float s = 0.f;
#pragma unroll
        for (int i = 0; i < 8; ++i) { const int d = (i * 64 + lane) * 4; const u32x2 yr = *(const u32x2*)(y1 + (size_t)tok * D + d); const f32x4 yv = {bflo(yr.x), bfhi(yr.x), bflo(yr.y), bfhi(yr.y)}, g = *(const f32x4*)(l1w + d), bb = *(const f32x4*)(l1b + d);
            f32x4 a = ((yv - mean1) * rstd1 * g + bb) * DN_ALPHA;
#pragma unroll
            for (int k = 0; k < 4; ++k) { const u32x2 v = *(const u32x2*)(yb + ((size_t)tok * 4 + k) * D + d); a[0] += bflo(v.x); a[1] += bfhi(v.x); a[2] += bflo(v.y); a[3] += bfhi(v.y); }
            z[i] = a; s += (a[0] + a[1]) + (a[2] + a[3]); }
#pragma unroll
        for (int o = 32; o >= 1; o >>= 1) s += __shfl_xor(s, o);
        const float mean = s * (1.0f / D); float qv = 0.f;
#pragma unroll
        for (int i = 0; i < 8; ++i) { const f32x4 dl = z[i] - mean; qv += (dl[0] * dl[0] + dl[1] * dl[1]) + (dl[2] * dl[2] + dl[3] * dl[3]); }
#pragma unroll
        for (int o = 32; o >= 1; o >>= 1) qv += __shfl_xor(qv, o);
        const float rstd = rsqrtf(qv * (1.0f / D) + LN_EPS);
#pragma unroll
        for (int i = 0; i < 8; ++i) { const int d = (i * 64 + lane) * 4; const f32x4 g = *(const f32x4*)(l2w + d), bb = *(const f32x4*)(l2b + d);
            const f32x4 xv = (z[i] - mean) * rstd * g + bb;
            *(u32x2*)(x2b + (size_t)tok * D + d) = pack4(xv); }
        float q2 = (lane < 32) ? ssq[(size_t)tok * 32 + lane] : 0.f;
#pragma unroll
        for (int o = 32; o >= 1; o >>= 1) q2 += __shfl_xor(q2, o);
        if (lane == 0) rse[tok] = rsqrtf(q2 * (1.0f / D) + LN_EPS); }
}

__global__ void __launch_bounds__(NTHR, 2) hybrid_fwd(Params P) {
    extern __shared__ __attribute__((aligned(16))) unsigned char lds_raw[];
    Ctx c; c.lds = (LAS unsigned char*)lds_raw; c.ws = P.ws; c.ctl = (unsigned*)(P.ws + WS_CTL);
    c.wid = __builtin_amdgcn_readfirstlane(threadIdx.x >> 6); c.bid = blockIdx.x; c.G = gridDim.x;
    volatile LAS unsigned* xbw = (volatile LAS unsigned*)(c.lds + LDS_BYTES - 16);
    if (threadIdx.x == 0) { xbw[0] = 0u; xbw[1] = 0u; xbw[2] = 0u; xbw[3] = 0u; }
    __syncthreads();
    const XcdBarrier bar = xcd_barrier_post(c.ctl, xbw);

#ifndef PHMASK
#define PHMASK 0xFFFF
#endif
#define PH(k) if ((PHMASK >> (k)) & 1)
#ifndef DBLMASK
#define DBLMASK 0
#endif
#define DBL(k) if ((DBLMASK >> (k)) & 1)
    PH(0) p0_prologue(c);
    DBL(0) p0_prologue(c);
    xcd_barrier(bar);
    PH(1) p1_gemm(c);
    DBL(1) p1_gemm(c);
    xcd_barrier(bar);
    PH(2) for (int u = c.bid; u < 512; u += c.G) ret_kv_unit(c, u);
    PH(3) for (int u = c.bid; u < 512; u += c.G) lru_local_unit(c, u);
    DBL(2) for (int u = c.bid; u < 512; u += c.G) ret_kv_unit(c, u);
    DBL(3) for (int u = c.bid; u < 512; u += c.G) lru_local_unit(c, u);
    xcd_barrier(bar);
    PH(4) for (int u = c.bid, k = 0; u < 512; u += c.G, ++k) ret_out_unit(c, (c.G == 256 && (k & 1)) ? (u ^ (15 << 3)) : u);
    PH(5) for (int u = c.bid, k = 0; u < 512; u += c.G, ++k) lru_fin_unit(c, (c.G == 256 && (k & 1)) ? (u ^ (15 << 3)) : u);
    DBL(4) for (int u = c.bid; u < 512; u += c.G) ret_out_unit(c, u);
    DBL(5) for (int u = c.bid; u < 512; u += c.G) lru_fin_unit(c, u);
    xcd_barrier(bar);
    PH(6) p3_gemm(c);
    DBL(6) p3_gemm(c);
    xcd_barrier(bar);
    PH(7) p4_ln_router(c);
    xcd_barrier(bar);
    PH(8) p5_moe_up(c);
    DBL(8) p5_moe_up(c);
    xcd_barrier(bar);
    PH(9) p6_moe_down(c);
    DBL(9) p6_moe_down(c);
    xcd_barrier(bar);
    PH(10) p7_ln2(c);
    DBL(10) p7_ln2(c);
    xcd_barrier(bar);
    PH(11) p8_gemm(c);
}
}

extern "C" void kernel_launch(void* const* d_in, const int* in_sizes, int n_in, void* d_out, int out_size, void* d_ws, size_t ws_size, hipStream_t stream) {
    static int grid = 0;
    if (grid == 0) {
        int dev = 0, cus = 0, per_cu = 0;
        if (n_in != 27 || ws_size < WS_END) { grid = -1; return; }
        if (hipGetDevice(&dev) != hipSuccess || hipDeviceGetAttribute(&cus, hipDeviceAttributeMultiprocessorCount, dev) != hipSuccess) { grid = -1; return; }
        if (hipFuncSetAttribute((const void*)hybrid_fwd, hipFuncAttributeMaxDynamicSharedMemorySize, LDS_BYTES) != hipSuccess) { grid = -1; return; }
        (void)hipOccupancyMaxActiveBlocksPerMultiprocessor(&per_cu, (const void*)hybrid_fwd, NTHR, LDS_BYTES);
        (void)hipGetLastError();
        if (per_cu < 1) { grid = -1; return; }
        grid = (cus / 8) * 8;
        if (grid > 256) grid = 256;
    }
    if (grid <= 0) return;
    (void)in_sizes; (void)out_size;
    (void)hipMemsetAsync((char*)d_ws + WS_CTL, 0, CTL_BYTES, stream);
    Params p{};
    for (int i = 0; i < 27; ++i) p.in[i] = (const float*)d_in[i];
    p.out = (float*)d_out; p.ws = (unsigned char*)d_ws;
    hipLaunchKernelGGL(hybrid_fwd, dim3(grid), dim3(NTHR), LDS_BYTES, stream, p);
}
```

```cpp
#include <hip/hip_runtime.h>
#include <stdint.h>

namespace {
#define LAS __attribute__((address_space(3)))
#define DI __device__ __forceinline__
typedef short bf16x8 __attribute__((ext_vector_type(8)));
typedef short s16x4 __attribute__((ext_vector_type(4)));
typedef float f32x4 __attribute__((ext_vector_type(4)));
typedef float f32x2 __attribute__((ext_vector_type(2)));
typedef __bf16 bf16x4_t __attribute__((ext_vector_type(4)));
typedef __bf16 bf16x2_t __attribute__((ext_vector_type(2)));
typedef unsigned u32x4 __attribute__((ext_vector_type(4)));
typedef unsigned u32x2 __attribute__((ext_vector_type(2)));
typedef unsigned short u16;

constexpr int T = 8192, D = 2048, SEQ = 2048, INC = 6144, RW = 1024, LW = 1024;
constexpr int NE = 32, PLE = 256, CHUNK = 128, NCH = 16, NHEAD = 8;
constexpr float LN_EPS = 1e-5f;
constexpr float DN_ALPHA = 1.189207115002721f;
constexpr int NTHR = 512;
constexpr int LDS_BYTES = 147456;
constexpr int LIST_CAP = 8192;

constexpr size_t WS_CTL   = 0;
constexpr size_t CTL_BYTES = 32768;
constexpr size_t WS_XB    = 65536;
constexpr size_t WS_PB    = WS_XB    + (size_t)T * D * 2;
constexpr size_t WS_ROPE  = WS_PB    + (size_t)T * PLE * 2;
constexpr size_t WS_PROJ  = WS_ROPE  + (size_t)SEQ * 64 * 2 * 4;
constexpr size_t WS_EP    = WS_PROJ  + (size_t)T * INC * 2;
constexpr size_t WS_SSQ   = WS_EP    + (size_t)T * D * 2;
constexpr size_t WS_KV    = WS_SSQ   + (size_t)T * 32 * 4;
constexpr size_t WS_ACUM  = WS_KV    + (size_t)512 * 128 * 128 * 4;
constexpr size_t WS_HLOC  = WS_ACUM  + (size_t)T * LW * 4;
constexpr size_t WS_CA    = WS_HLOC  + (size_t)T * LW * 4;
constexpr size_t WS_CH    = WS_CA    + (size_t)4 * 16 * 1024 * 4;
constexpr size_t WS_MIXED = WS_CH    + (size_t)4 * 16 * 1024 * 4;
constexpr size_t WS_Y1    = WS_MIXED + (size_t)T * D * 2;
constexpr size_t WS_X1B   = WS_Y1    + (size_t)T * D * 4;
constexpr size_t WS_ST1   = WS_X1B   + (size_t)T * D * 2;
constexpr size_t WS_LID   = WS_ST1   + (size_t)T * 2 * 4;
constexpr size_t WS_LGT   = WS_LID   + (size_t)NE * LIST_CAP * 4;
constexpr size_t WS_HID   = WS_LGT   + (size_t)NE * LIST_CAP * 4;
constexpr size_t WS_YBUF  = WS_HID   + (size_t)41984 * 2048 * 2;
constexpr size_t WS_X2B   = WS_YBUF  + (size_t)32768 * 2048 * 2;
constexpr size_t WS_RSE   = WS_X2B   + (size_t)T * D * 2;
constexpr size_t WS_END   = WS_RSE   + (size_t)T * 4;

constexpr int CW_CNT = 4096;

#define XB_TMO      128
#define XB_XCNT(j)  (256  + 64 * (j))
#define XB_XSUB(j)  (1280 + 64 * (j))
#define XB_XGEN(j)  (2304 + 64 * (j))
#define XB_TOP      3328
#define XB_TOPGEN   3392
#define XCD_BAR_WORDS 3456
#define XB_SPIN_CAP (1u << 18)

DI unsigned xb_ld(unsigned* p)              { return __hip_atomic_load(p, __ATOMIC_RELAXED, __HIP_MEMORY_SCOPE_AGENT); }
DI unsigned xb_add(unsigned* p, unsigned v) { return __hip_atomic_fetch_add(p, v, __ATOMIC_RELAXED, __HIP_MEMORY_SCOPE_AGENT); }
DI unsigned xb_xcc_id() { return (unsigned)__builtin_amdgcn_s_getreg((3 << 11) | 20) & 0xFu; }
#define XB_SPIN(cond, bar) do { unsigned _sp = 0; while (cond) { __builtin_amdgcn_s_sleep(1); \
    if ((++_sp & 255u) == 0u) { if (xb_ld(&(bar)[XB_TMO])) break; if (_sp > XB_SPIN_CAP) { atomicAdd(&(bar)[XB_TMO], 1u); break; } } } } while (0)

struct XcdBarrier { unsigned* bar; unsigned x; volatile LAS unsigned* st; };

DI XcdBarrier xcd_barrier_post(unsigned* bar, volatile LAS unsigned* st) {
    XcdBarrier b; b.bar = bar; b.x = xb_xcc_id(); b.st = st;
    if (threadIdx.x == 0) (void)xb_add(&bar[XB_XCNT(b.x)], 1u);
    return b;
}
DI void xcd_barrier_complete(unsigned* bar, unsigned x, unsigned& nloc, unsigned& nx) {
    const unsigned G = gridDim.x * gridDim.y * gridDim.z;
    unsigned sum, cnt, mine, sp = 0u;
    for (;;) {
        sum = 0u; cnt = 0u; mine = 0u;
#pragma unroll
        for (unsigned j = 0; j < 16; ++j) { const unsigned c = xb_ld(&bar[XB_XCNT(j)]); sum += c; cnt += (c > 0u) ? 1u : 0u; mine = (j == x) ? c : mine; }
        if (sum == G) break;
        __builtin_amdgcn_s_sleep(1);
        if ((++sp & 255u) == 0u) { if (xb_ld(&bar[XB_TMO])) break; if (sp > XB_SPIN_CAP) { atomicAdd(&bar[XB_TMO], 1u); break; } }
    }
    nloc = mine > 0u ? mine : 1u; nx = cnt > 0u ? cnt : 1u;
}
DI void xcd_barrier(const XcdBarrier& b) {
    asm volatile("s_waitcnt vmcnt(0)" ::: "memory");
    __syncthreads();
    if (threadIdx.x == 0) {
        unsigned* bar = b.bar;
        __builtin_amdgcn_s_waitcnt(0);
        unsigned nloc = b.st[0], nx = b.st[1];
        if (nloc == 0u) { xcd_barrier_complete(bar, b.x, nloc, nx); b.st[0] = nloc; b.st[1] = nx; }
        const unsigned old = xb_add(&bar[XB_XSUB(b.x)], 1u);
        const unsigned gen = old / nloc;
        if (old + 1u == (gen + 1u) * nloc) {
            __builtin_amdgcn_fence(__ATOMIC_RELEASE, "agent");
            asm volatile("s_waitcnt vmcnt(0)" ::: "memory");
            const unsigned og = xb_add(&bar[XB_TOP], 1u);
            const unsigned tg = og / nx;
            if (og + 1u == (tg + 1u) * nx) xb_add(&bar[XB_TOPGEN], 1u);
            else XB_SPIN(xb_ld(&bar[XB_TOPGEN]) == tg, bar);
            __builtin_amdgcn_fence(__ATOMIC_ACQUIRE, "agent");
            xb_add(&bar[XB_XGEN(b.x)], 1u);
            asm volatile("s_waitcnt vmcnt(0)" ::: "memory");
        } else {
            XB_SPIN(xb_ld(&bar[XB_XGEN(b.x)]) == gen, bar);
            __builtin_amdgcn_fence(__ATOMIC_ACQUIRE, "agent");
            asm volatile("s_waitcnt vmcnt(0)" ::: "memory");
        }
    }
    __syncthreads();
}

DI float bf2f(u16 v) { return __uint_as_float(((unsigned)v) << 16); }
DI float bflo(unsigned w) { return __uint_as_float(w << 16); }
DI float bfhi(unsigned w) { return __uint_as_float(w & 0xffff0000u); }
DI unsigned pack2(float a, float b) { f32x2 v = {a, b}; bf16x2_t r = __builtin_convertvector(v, bf16x2_t); return __builtin_bit_cast(unsigned, r); }
DI u32x2 pack4(f32x4 v) { bf16x4_t r = __builtin_convertvector(v, bf16x4_t); return __builtin_bit_cast(u32x2, r); }
DI float sigmoidf_(float x) { return __builtin_amdgcn_rcpf(1.0f + __expf(-x)); }
DI float gelu_tanh(float x) { const float u = 0.7978845608028654f * (x + 0.044715f * x * x * x); const float e = __expf(2.0f * u); const float th = 1.0f - 2.0f / (e + 1.0f); return 0.5f * x * (1.0f + th); }
#define LP(type, addr) ((LAS type*)(uintptr_t)(addr))
DI s16x4 tr_read(unsigned byte_addr) { return __builtin_amdgcn_ds_read_tr16_b64_v4i16(LP(s16x4, byte_addr)); }
DI s16x4 tr_read_na(LAS s16x4* __restrict__ p) { return __builtin_amdgcn_ds_read_tr16_b64_v4i16(p); }
DI bf16x8 cat8(s16x4 lo, s16x4 hi) { return __builtin_shufflevector(lo, hi, 0, 1, 2, 3, 4, 5, 6, 7); }
#define MFMA16(a, b, c) __builtin_amdgcn_mfma_f32_16x16x32_bf16((a), (b), (c), 0, 0, 0)
DI int trrow(int k) { return k ^ ((k >> 1) & 4); }

DI int lane_id() { int l; asm volatile("v_mbcnt_lo_u32_b32 %0, -1, 0\n\tv_mbcnt_hi_u32_b32 %0, -1, %0" : "=v"(l)); return l; }

struct Params {
    const float* in[27];
    float* out;
    unsigned char* ws;
};
typedef const __attribute__((address_space(4))) Params* KPtr;
DI KPtr kargs() { KPtr p = (KPtr)__builtin_amdgcn_kernarg_segment_ptr(); asm volatile("" : "+s"(p)); return p; }

constexpr int G_BSTRIDE = 544, G_BBUF = 64 * G_BSTRIDE, G_B0 = 0, G_B1 = G_BBUF, G_AREG = 0;
#define OPAQUE_LDS(p) asm volatile("" : "+v"(p))
typedef int i32x4 __attribute__((ext_vector_type(4)));
DI __amdgpu_buffer_rsrc_t mk_rsrc(const void* p) { return __builtin_amdgcn_make_buffer_rsrc((void*)p, 0, 0x7FFFFFF0, 0x00020000); }
DI u32x4 bload16(__amdgpu_buffer_rsrc_t r, unsigned voff, unsigned soff) { return __builtin_bit_cast(u32x4, __builtin_amdgcn_raw_buffer_load_b128(r, (int)voff, (int)soff, 0)); }

template <bool GU, class U, class S, int MF = 8>
DI void gemm_stream(LAS unsigned char* lds, const int wid, int nt, const int ldb, const S& sched) {
    constexpr int ABUF = MF * 4096, G_A0 = 0, G_A1 = ABUF, G_BREG = 2 * ABUF, NG = 2 * MF;
    asm volatile("" : "+s"(nt));
    const int lane = lane_id(), wr = wid >> 2, wc = wid & 3, fr = lane & 15, fq = lane >> 4;
    U cur;
    if (!sched.get(0, cur)) return;
    __amdgpu_buffer_rsrc_t rsB0, rsB1, rsA; unsigned voa0, voa1, voa2, voa3, voa4 = 0;
#define G_SETUP_B(u) do { rsB0 = mk_rsrc((u).b0); rsB1 = mk_rsrc((u).b1); } while (0)
#define G_SETUP_A(u) do { \
        const int _l = lane_id(), sb_ = _l * 16, swz = sb_ ^ (((sb_ >> 9) & 1) << 5); \
        const int R0 = (wid >> 1) * 16 + (swz >> 6), C0 = (wid & 1) * 32 + ((swz & 63) >> 1); \
        rsA = mk_rsrc((u).al.base()); \
        voa0 = (u).al.rowoff(R0) + C0 * 2; voa1 = (u).al.rowoff(R0 + 64) + C0 * 2; voa2 = (u).al.rowoff(R0 + 128) + C0 * 2; voa3 = (u).al.rowoff(R0 + 192) + C0 * 2; \
        if (MF == 9) voa4 = (u).al.rowoff(256 + ((wid >> 1) & 1) * 16 + (swz >> 6)) + C0 * 2;        \
        } while (0)
#define G_SETUP(u) do { G_SETUP_B(u); G_SETUP_A(u); } while (0)
    G_SETUP(cur);
    const int hl = lane >> 5, sc = (lane & 31) * 4;
    const unsigned vob = (unsigned)((2 * wid + hl) * ldb + sc) * 4u;
    const unsigned kstepB = (unsigned)ldb * 64u;
    const int pos0 = (GU ? (sc >> 5) * 64 : (sc & ~31)) + ((sc >> 2) & 1) * 16 + ((sc >> 3) & 3) * 4;
    LAS unsigned char* b_wr = lds + G_BREG + (((2 * wid + hl) ^ (wid & 4)) * G_BSTRIDE) + pos0 * 2; OPAQUE_LDS(b_wr);
    constexpr int SLAB1 = GU ? 64 : 256;
    LAS unsigned char* a_rd = lds + G_AREG + wr * (MF * 2048) + ((fr * 64 + fq * 16) ^ (((fr >> 3) & 1) << 5)); OPAQUE_LDS(a_rd);
    const int q = (lane & 15) >> 2, p = lane & 3;
    LAS unsigned char* b_rd0 = lds + G_BREG + fq * (8 * G_BSTRIDE) + (((fq & 1) * 4 + q) * G_BSTRIDE) + wc * 128 + p * 8; OPAQUE_LDS(b_rd0);
    LAS unsigned char* b_rd1 = lds + G_BREG + fq * (8 * G_BSTRIDE) + ((((fq & 1) ^ 1) * 4 + q) * G_BSTRIDE) + wc * 128 + p * 8; OPAQUE_LDS(b_rd1);

    f32x4 acc[MF][4];
    u32x4 sb[8];
    LAS unsigned char* a_dma = lds + G_AREG + wid * 1024;

#define G_DMA_A(kt, AO) do { G_DMA1(kt, AO, 0); G_DMA1(kt, AO, 1); G_DMA1(kt, AO, 2); G_DMA1(kt, AO, 3); if (MF == 9) G_DMA5(kt, AO); } while (0)
#define G_ISSUE_B(kt) do { const unsigned _sb = (unsigned)(kt) * 4u * kstepB; \
        _Pragma("unroll") for (int _i = 0; _i < 8; ++_i) sb[_i] = bload16(_i < 4 ? rsB0 : rsB1, vob, _sb + (_i & 3) * kstepB); } while (0)
#define G_WRITE_B(BO) do { \
        _Pragma("unroll") for (int _i = 0; _i < 8; ++_i) *(LAS u32x2*)(b_wr + (BO) + (_i & 3) * (16 * G_BSTRIDE) + (_i >> 2) * SLAB1) = pack4(__builtin_bit_cast(f32x4, sb[_i])); } while (0)
#define G_DMA1(kt, AO, pc) __builtin_amdgcn_raw_ptr_buffer_load_lds(rsA, (LAS void*)(a_dma + (AO) + (pc) * 8192), 16, (int)((pc) == 0 ? voa0 : (pc) == 1 ? voa1 : (pc) == 2 ? voa2 : voa3), (int)((unsigned)(kt) * 128u), 0, 0)
#define G_DMA5(kt, AO) __builtin_amdgcn_raw_ptr_buffer_load_lds(rsA, (LAS void*)(lds + G_AREG + (AO) + 32768 + (wid & 3) * 1024), 16, (int)voa4, (int)((unsigned)(kt) * 128u), 0, 0)
#define G_WR1(BO, i) (*(LAS u32x2*)(b_wr + (BO) + ((i) & 3) * (16 * G_BSTRIDE) + ((i) >> 2) * SLAB1) = pack4(__builtin_bit_cast(f32x4, sb[i])))
#define G_LD1(kt, i) (sb[i] = bload16(((i) < 4) ? rsB0 : rsB1, vob, (unsigned)(kt) * 4u * kstepB + (unsigned)((i) & 3) * kstepB))
#define G_RD_A(AO, ks, m) (*(const LAS bf16x8*)(a_rd + (AO) + (m) * 2048 + (ks) * 1024))
#define G_TR(BO, ks, n) cat8(tr_read_na((LAS s16x4*)(b_rd0 + (BO) + (ks) * (32 * G_BSTRIDE) + (n) * 32)), \
                             tr_read_na((LAS s16x4*)(b_rd1 + (BO) + (ks) * (32 * G_BSTRIDE) + (n) * 32)))
#define G_TILE(AR, BR, DO_MEM, BW, AW, kA, HAS_B, kB, HOOK) do { \
        bf16x8 Bf[4], Af[3]; \
        _Pragma("unroll") for (int n = 0; n < 4; ++n) Bf[n] = G_TR(BR, 0, n); \
        Af[0] = G_RD_A(AR, 0, 0); Af[1] = G_RD_A(AR, 0, 1); \
        _Pragma("unroll") for (int g = 0; g < NG; ++g) { const int m = g % MF; \
            if (g < NG - 2) Af[(g + 2) % 3] = G_RD_A(AR, (g + 2) / MF, (g + 2) % MF); \
            if (DO_MEM && g == 0) { G_DMA1(kA, AW, 0); G_DMA1(kA, AW, 1); G_DMA1(kA, AW, 2); G_DMA1(kA, AW, 3); if (MF == 9) G_DMA5(kA, AW); HOOK; } \
            _Pragma("unroll") for (int n = 0; n < 4; ++n) { acc[m][n] = MFMA16(Bf[n], Af[g % 3], acc[m][n]); \
                if (g == MF - 1) Bf[n] = G_TR(BR, 1, n); }            \
            if (DO_MEM && (g & 1) && g < 16) { G_WR1(BW, g >> 1); __builtin_amdgcn_sched_barrier(0); if (HAS_B) G_LD1(kB, g >> 1); } \
            __builtin_amdgcn_sched_barrier(0); } \
    } while (0)
#define G_ENDTILE(VM) do { asm volatile("s_waitcnt vmcnt(" #VM ")" ::: "memory"); \
        asm volatile("s_waitcnt lgkmcnt(0)" ::: "memory"); __builtin_amdgcn_s_barrier(); asm volatile("" ::: "memory"); } while (0)

    __builtin_amdgcn_s_barrier();
    G_DMA_A(0, G_A0); G_ISSUE_B(0); G_WRITE_B(G_B0);
    __builtin_amdgcn_sched_barrier(0);
    G_ISSUE_B(1);
    __builtin_amdgcn_sched_barrier(0);
    G_ENDTILE(8);
    for (int ui = 0;; ++ui) {
#pragma unroll
        for (int m = 0; m < MF; ++m)
#pragma unroll
            for (int n = 0; n < 4; ++n) acc[m][n] = (f32x4){0.f, 0.f, 0.f, 0.f};
        for (int t = 0; t < nt - 2; t += 2) {
            G_TILE(G_A0, G_B0, true, G_B1, G_A1, t + 1, true, t + 2, (void)0);
            G_ENDTILE(8);
            G_TILE(G_A1, G_B1, true, G_B0, G_A0, t + 2, true, t + 3, (void)0);
            G_ENDTILE(8);
        }
        U nxt = cur;
        const bool has_next = sched.get(ui + 1, nxt);
        G_SETUP_B(nxt);
        G_TILE(G_A0, G_B0, true, G_B1, G_A1, nt - 1, true, 0, G_SETUP_A(nxt));
        G_ENDTILE(8);
        G_TILE(G_A1, G_B1, true, G_B0, G_A0, 0, true, 1, (void)0);
        G_ENDTILE(8);
        { const int l2 = lane_id(); cur.ep(acc, wr, wc, l2 & 15, l2 >> 4); }
        if (!has_next) break;
        cur = nxt;
    }
    asm volatile("s_waitcnt vmcnt(0)" ::: "memory");
#undef G_SETUP_A
#undef G_SETUP_B
#undef G_SETUP
#undef G_DMA_A
#undef G_ISSUE_B
#undef G_WRITE_B
#undef G_DMA1
#undef G_DMA5
#undef G_WR1
#undef G_LD1
#undef G_RD_A
#undef G_TR
#undef G_TILE
#undef G_ENDTILE
}

struct ARows { const u16* b; int lda; DI const void* base() const { return b; } DI unsigned rowoff(int r) const { return (unsigned)(r * lda) * 2u; } };
struct AGather { const u16* x; const int* ids; int m0, cnt; DI const void* base() const { return x; }
    DI unsigned rowoff(int r) const { int i = m0 + r; i = i < cnt ? i : cnt - 1;
        const unsigned v = (unsigned)__builtin_amdgcn_raw_buffer_load_b32(__builtin_amdgcn_make_buffer_rsrc((void*)ids, 0, 0x7FFFFFF0, 0x00020000), i * 4, 0, 0);
        return (v >> 2) * (unsigned)(D * 2); } };

struct Ctx {
    LAS unsigned char* lds; unsigned char* ws; unsigned* ctl; int wid, bid, G;
};

DI void p0_prologue(const Ctx& c) {
    const KPtr kp = kargs();
    const int tid = c.wid * 64 + lane_id();
    const size_t gt = (size_t)c.bid * NTHR + tid, gs = (size_t)c.G * NTHR;
    { const f32x4* src = (const f32x4*)kp->in[0]; u32x4* dst = (u32x4*)(c.ws + WS_XB);
      for (size_t i = gt; i < (size_t)T * D / 8; i += gs) { const f32x4 a = src[2 * i], b = src[2 * i + 1]; const u32x2 lo = pack4(a), hi = pack4(b); dst[i] = (u32x4){lo.x, lo.y, hi.x, hi.y}; } }
    { const f32x4* src = (const f32x4*)kp->in[1]; u32x4* dst = (u32x4*)(c.ws + WS_PB);
      for (size_t i = gt; i < (size_t)T * PLE / 8; i += gs) { const f32x4 a = src[2 * i], b = src[2 * i + 1]; const u32x2 lo = pack4(a), hi = pack4(b); dst[i] = (u32x4){lo.x, lo.y, hi.x, hi.y}; } }
    { f32x2* rope = (f32x2*)(c.ws + WS_ROPE);
      for (size_t i = gt; i < (size_t)SEQ * 64; i += gs) { const int pos = (int)(i >> 6), k = (int)(i & 63);
        const float inv = exp2f(-(float)k * (13.287712379549449f / 64.0f));
        const float ang = (float)pos * inv;
        double rv = (double)ang * 0.15915494309189535; rv -= floor(rv);
        const float f = (float)rv;
        rope[i] = (f32x2){__builtin_amdgcn_cosf(f), __builtin_amdgcn_sinf(f)}; } }
}

struct EpiProj { u16* out; int row0, col0;
    DI void operator()(const f32x4 (&acc)[8][4], int wr, int wc, int fr, int fq) const {
#pragma unroll
        for (int m = 0; m < 8; ++m) { u16* rp = out + (size_t)(row0 + wr * 128 + m * 16 + fr) * INC + col0 + wc * 64 + 8 * fq;
#pragma unroll
            for (int h = 0; h < 2; ++h) { const u32x2 lo = pack4(acc[m][2 * h]), hi = pack4(acc[m][2 * h + 1]); *(u32x4*)(rp + h * 32) = (u32x4){lo.x, lo.y, hi.x, hi.y}; } }
    } };
struct EpiPle { u16* out; float* ssq; int row0, ntile;
    DI void operator()(const f32x4 (&acc)[8][4], int wr, int wc, int fr, int fq) const {
#pragma unroll
        for (int m = 0; m < 8; ++m) { const int row = row0 + wr * 128 + m * 16 + fr; u16* rp = out + (size_t)row * D + ntile * 256 + wc * 64 + 8 * fq; float s = 0.f;
#pragma unroll
            for (int n = 0; n < 4; ++n) { const f32x4 v = acc[m][n]; s += (v[0] * v[0] + v[1] * v[1]) + (v[2] * v[2] + v[3] * v[3]); }
#pragma unroll
            for (int h = 0; h < 2; ++h) { const u32x2 lo = pack4(acc[m][2 * h]), hi = pack4(acc[m][2 * h + 1]); *(u32x4*)(rp + h * 32) = (u32x4){lo.x, lo.y, hi.x, hi.y}; }
            s += __shfl_xor(s, 16); s += __shfl_xor(s, 32);
            if (fq == 0) ssq[(size_t)row * 32 + ntile * 4 + wc] = s; }
    } };
struct EpiY1 { const u16* x; u16* y; int row0, col0;
    DI void operator()(const f32x4 (&acc)[8][4], int wr, int wc, int fr, int fq) const {
#pragma unroll
        for (int m = 0; m < 8; ++m) { const size_t off = (size_t)(row0 + wr * 128 + m * 16 + fr) * D + col0 + wc * 64 + 8 * fq;
#pragma unroll
            for (int h = 0; h < 2; ++h) { const u32x4 xr = *(const u32x4*)(x + off + h * 32);
                const f32x4 x0 = {bflo(xr.x), bfhi(xr.x), bflo(xr.y), bfhi(xr.y)}, x1 = {bflo(xr.z), bfhi(xr.z), bflo(xr.w), bfhi(xr.w)};
                const u32x2 lo = pack4(x0 * DN_ALPHA + acc[m][2 * h]), hi = pack4(x1 * DN_ALPHA + acc[m][2 * h + 1]); *(u32x4*)(y + off + h * 32) = (u32x4){lo.x, lo.y, hi.x, hi.y}; } }
    } };
struct EpiHid { u16* hid; const float* bg; const float* bu; int row0, hc0;
    template <int MF> DI void operator()(const f32x4 (&acc)[MF][4], int wr, int wc, int fr, int fq) const {
        const int hc = hc0 + wc * 32 + 8 * fq;
        f32x4 bgv[2], buv[2];
#pragma unroll
        for (int n = 0; n < 2; ++n) { bgv[n] = *(const f32x4*)(bg + hc + 4 * n); buv[n] = *(const f32x4*)(bu + hc + 4 * n); }
#pragma unroll
        for (int m = 0; m < MF; ++m) { u16* rp = hid + (size_t)(row0 + wr * (16 * MF) + m * 16 + fr) * D + hc; u32x2 w[2];
#pragma unroll
            for (int n = 0; n < 2; ++n) { f32x4 g = acc[m][n] + bgv[n], u = acc[m][n + 2] + buv[n], h;
#pragma unroll
                for (int j = 0; j < 4; ++j) { const float gt = fminf(g[j], 7.0f); const float up = fminf(fmaxf(u[j], -7.0f), 7.0f); h[j] = (up + 1.0f) * gt * sigmoidf_(1.702f * gt); }
                w[n] = pack4(h); }
            *(u32x4*)rp = (u32x4){w[0].x, w[0].y, w[1].x, w[1].y}; }
    } };
struct EpiDown { u16* ybuf; const float* bd; const int* ids; const float* gts; int m0, cnt, col0;
    template <int MF> DI void operator()(const f32x4 (&acc)[MF][4], int wr, int wc, int fr, int fq) const {
        f32x4 bv[4];
#pragma unroll
        for (int n = 0; n < 4; ++n) bv[n] = *(const f32x4*)(bd + col0 + wc * 64 + 32 * (n >> 1) + 8 * fq + 4 * (n & 1));
#pragma unroll
        for (int m = 0; m < MF; ++m) { const int i = m0 + wr * (16 * MF) + m * 16 + fr;
            if (i < cnt) { const int id = ids[i]; const float g = gts[i]; u16* rp = ybuf + (size_t)id * D + col0 + wc * 64 + 8 * fq;
#pragma unroll
                for (int h = 0; h < 2; ++h) { const u32x2 lo = pack4((acc[m][2 * h] + bv[2 * h]) * g), hi = pack4((acc[m][2 * h + 1] + bv[2 * h + 1]) * g);
                    *(u32x4*)(rp + h * 32) = (u32x4){lo.x, lo.y, hi.x, hi.y}; } } }
    } };
struct EpiOut { float* out; const u16* x2b; const u16* ep; const float* rse; const float* pnw; int row0, col0;
    DI void operator()(const f32x4 (&acc)[8][4], int wr, int wc, int fr, int fq) const {
        f32x4 wv[4];
#pragma unroll
        for (int n = 0; n < 4; ++n) wv[n] = *(const f32x4*)(pnw + col0 + wc * 64 + 32 * (n >> 1) + 8 * fq + 4 * (n & 1));
#pragma unroll
        for (int m = 0; m < 8; ++m) { const int row = row0 + wr * 128 + m * 16 + fr; const float rs = rse[row]; const size_t off = (size_t)row * D + col0 + wc * 64 + 8 * fq;
#pragma unroll
            for (int h = 0; h < 2; ++h) { const u32x4 xr = *(const u32x4*)(x2b + off + h * 32), er = *(const u32x4*)(ep + off + h * 32);
                const unsigned xw[4] = {xr.x, xr.y, xr.z, xr.w}, ew[4] = {er.x, er.y, er.z, er.w};
#pragma unroll
                for (int q = 0; q < 2; ++q) { const f32x4 a = acc[m][2 * h + q]; const f32x4 w4 = wv[2 * h + q]; f32x4 o;
                    o[0] = bflo(xw[2 * q]) + sigmoidf_(a[0]) * bflo(ew[2 * q]) * rs * w4[0]; o[1] = bfhi(xw[2 * q]) + sigmoidf_(a[1]) * bfhi(ew[2 * q]) * rs * w4[1];
                    o[2] = bflo(xw[2 * q + 1]) + sigmoidf_(a[2]) * bflo(ew[2 * q + 1]) * rs * w4[2]; o[3] = bfhi(xw[2 * q + 1]) + sigmoidf_(a[3]) * bfhi(ew[2 * q + 1]) * rs * w4[3];
                    *(f32x4*)(out + off + h * 32 + 4 * q) = o; } } }
    } };

DI bool deal_tiles(int bid, int G, int nM, int nN, int i, int& pm, int& pn) {
    const int x = bid & 7, r = bid >> 3, W = G >> 3;
    const int mper = nM >> 3;
    const int q = i * W + r;
    if (q >= mper * nN) return false;
    pm = x * mper + (q % mper); pn = q / mper; return true;
}

template <class EP> struct UnitD { ARows al; const float* b0; const float* b1; EP ep; DI int rows() const { return 256; } };
struct SchedProj { int bid, G; const u16* xb; const float* w; u16* proj;
    DI bool get(int i, UnitD<EpiProj>& u) const { int pm, pn; if (!deal_tiles(bid, G, T / 256, INC / 256, i, pm, pn)) return false;
        u.al = ARows{xb + (size_t)pm * 256 * D, D}; u.b0 = w + pn * 256; u.b1 = u.b0 + 128; u.ep = EpiProj{proj, pm * 256, pn * 256}; return true; } };
struct SchedPle { int bid, G; const u16* pb; const float* w; u16* epo; float* ssq;
    DI bool get(int i, UnitD<EpiPle>& u) const { int pm, pn; if (!deal_tiles(bid, G, T / 256, D / 256, i, pm, pn)) return false;
        u.al = ARows{pb + (size_t)pm * 256 * PLE, PLE}; u.b0 = w + pn * 256; u.b1 = u.b0 + 128; u.ep = EpiPle{epo, ssq, pm * 256, pn}; return true; } };
struct SchedY1 { int bid, G; const u16* mx; const float* w; const u16* x; u16* y;
    DI bool get(int i, UnitD<EpiY1>& u) const { int pm, pn; if (!deal_tiles(bid, G, T / 256, D / 256, i, pm, pn)) return false;
        u.al = ARows{mx + (size_t)pm * 256 * D, D}; u.b0 = w + pn * 256; u.b1 = u.b0 + 128; u.ep = EpiY1{x, y, pm * 256, pn * 256}; return true; } };
struct SchedOut { int bid, G; const u16* xb; const float* w; float* out; const u16* epi; const float* rse; const float* pnw;
    DI bool get(int i, UnitD<EpiOut>& u) const { int pm, pn; if (!deal_tiles(bid, G, T / 256, D / 256, i, pm, pn)) return false;
        u.al = ARows{xb + (size_t)pm * 256 * D, D}; u.b0 = w + pn * 256; u.b1 = u.b0 + 128; u.ep = EpiOut{out, xb, epi, rse, pnw, pm * 256, pn * 256}; return true; } };

DI void p1_gemm(const Ctx& c) {
    const KPtr kp = kargs();
    { const SchedProj S{c.bid, c.G, (const u16*)(c.ws + WS_XB), kp->in[2], (u16*)(c.ws + WS_PROJ)};
      gemm_stream<false, UnitD<EpiProj>>(c.lds, c.wid, D / 64, INC, S); }
}
DI void ple_gemm(const Ctx& c) {
    const KPtr kp = kargs();
    const SchedPle S{c.bid, c.G, (const u16*)(c.ws + WS_PB), kp->in[24], (u16*)(c.ws + WS_EP), (float*)(c.ws + WS_SSQ)};
    gemm_stream<false, UnitD<EpiPle>>(c.lds, c.wid, PLE / 64, D, S);
}
DI void p3_gemm(const Ctx& c) {
    const KPtr kp = kargs();
    const SchedY1 S{c.bid, c.G, (const u16*)(c.ws + WS_MIXED), kp->in[11], (const u16*)(c.ws + WS_XB), (u16*)(c.ws + WS_Y1)};
    gemm_stream<false, UnitD<EpiY1>>(c.lds, c.wid, D / 64, D, S);
}
DI void p8_gemm(const Ctx& c) {
    const KPtr kp = kargs();
    const SchedOut S{c.bid, c.G, (const u16*)(c.ws + WS_X2B), kp->in[26], kp->out, (const u16*)(c.ws + WS_EP), (const float*)(c.ws + WS_RSE), kp->in[25]};
    gemm_stream<false, UnitD<EpiOut>>(c.lds, c.wid, D / 64, D, S);
}

constexpr int MOE_MF = 9, MOE_BM = 32 * MOE_MF;
constexpr int MS_OFF = 143424;
template <bool ALL>
DI void moe_build_sched(const Ctx& c) {
    LAS int* S = (LAS int*)(c.lds + MS_OFF);
    __syncthreads();
    if (c.wid == 0) {
        const int lane = lane_id(), x = c.bid & 7;
        const int myc = (lane < NE) ? (int)c.ctl[CW_CNT + 64 * lane] : 0;
        int load[8] = {0, 0, 0, 0, 0, 0, 0, 0}; int hb = 0, nown = 0;
#pragma unroll
        for (int e = 0; e < NE; ++e) { const int cn = __builtin_amdgcn_readlane(myc, e), mc = (cn + MOE_BM - 1) / MOE_BM;
            int best = 0, bl = load[0];
#pragma unroll
            for (int j = 1; j < 8; ++j) { const bool lt = load[j] < bl; bl = lt ? load[j] : bl; best = lt ? j : best; }
#pragma unroll
            for (int j = 0; j < 8; ++j) load[j] += (j == best) ? mc : 0;
            if ((ALL || best == x) && mc > 0) { if (lane == 0) { S[8 + 4 * nown] = e; S[9 + 4 * nown] = mc; S[10 + 4 * nown] = cn; S[11 + 4 * nown] = hb; } ++nown; }
            hb += mc * MOE_BM; }
        if (lane == 0) S[0] = nown;
    }
    __syncthreads();
}
DI bool moe_find(const Ctx& c, int qi, int NT, int& e, int& nt, int& mt, int& cn, int& hb) {
    LAS int* S = (LAS int*)(c.lds + MS_OFF);
    const int nown = __builtin_amdgcn_readfirstlane(S[0]); int accu = 0;
    for (int k = 0; k < nown; ++k) { const int mc = __builtin_amdgcn_readfirstlane(S[9 + 4 * k]);
        if (qi < accu + NT * mc) { const int loc = qi - accu; nt = loc / mc; mt = loc - nt * mc;
            e = __builtin_amdgcn_readfirstlane(S[8 + 4 * k]); cn = __builtin_amdgcn_readfirstlane(S[10 + 4 * k]); hb = __builtin_amdgcn_readfirstlane(S[11 + 4 * k]); return true; }
        accu += NT * mc; }
    return false;
}
struct UnitUp { AGather al; const float* b0; const float* b1; EpiHid ep; int nrows; DI int rows() const { return nrows; } };
struct SchedUp { const Ctx& c; int r, W; const u16* x1b; const int* lid; const float* wg; const float* wu; const float* bg; const float* bu; u16* hid;
    DI bool get(int i, UnitUp& u) const { int e, nt, mt, cn, hb; if (!moe_find(c, r + i * W, 2, e, nt, mt, cn, hb)) return false; nt = (c.bid & 7) + 8 * nt;
        u.al = AGather{x1b, lid + e * LIST_CAP, mt * MOE_BM, cn}; u.b0 = wg + (size_t)e * D * D + nt * 128; u.b1 = wu + (size_t)e * D * D + nt * 128;
        u.ep = EpiHid{hid, bg + e * D, bu + e * D, hb + mt * MOE_BM, nt * 128}; u.nrows = cn - mt * MOE_BM; return true; } };
struct UnitDown { ARows al; const float* b0; const float* b1; EpiDown ep; int nrows; DI int rows() const { return nrows; } };
struct SchedDown { const Ctx& c; int r, W; const u16* hid; const int* lid; const float* lgt; const float* wd; const float* bd; u16* ybuf;
    DI bool get(int i, UnitDown& u) const { int e, nt, mt, cn, hb; if (!moe_find(c, r + i * W, 8, e, nt, mt, cn, hb)) return false;
        u.al = ARows{hid + (size_t)(hb + mt * MOE_BM) * D, D}; u.b0 = wd + (size_t)e * D * D + nt * 256; u.b1 = u.b0 + 128;
        u.ep = EpiDown{ybuf, bd + e * D, lid + e * LIST_CAP, lgt + e * LIST_CAP, mt * MOE_BM, cn, nt * 256}; u.nrows = cn - mt * MOE_BM; return true; } };
DI void p5_moe_up(const Ctx& c) {
    const KPtr kp = kargs();
    moe_build_sched<true>(c);
    const SchedUp S{c, c.bid >> 3, c.G >> 3, (const u16*)(c.ws + WS_X1B), (const int*)(c.ws + WS_LID), kp->in[16], kp->in[18], kp->in[17], kp->in[19], (u16*)(c.ws + WS_HID)};
    gemm_stream<true, UnitUp, SchedUp, MOE_MF>(c.lds, c.wid, D / 64, D, S);
}
DI void p6_moe_down(const Ctx& c) {
    const KPtr kp = kargs();
    moe_build_sched<false>(c);
    const SchedDown S{c, c.bid >> 3, c.G >> 3, (const u16*)(c.ws + WS_HID), (const int*)(c.ws + WS_LID), (const float*)(c.ws + WS_LGT), kp->in[20], kp->in[21], (u16*)(c.ws + WS_YBUF)};
    gemm_stream<false, UnitDown, SchedDown, MOE_MF>(c.lds, c.wid, D / 64, D, S);
}

DI float head_log_gamma(int h) { return log1pf(-exp2f(-5.0f - (float)h)); }

template <bool TRIMG>
DI void stage_rope(const Ctx& c, unsigned dst, int stride, int t0, int col0, int pos0, float scale, float lg, bool kdec) {
    const u16* proj = (const u16*)(c.ws + WS_PROJ); const f32x2* rope = (const f32x2*)(c.ws + WS_ROPE); const int tid = c.wid * 64 + lane_id();
#pragma unroll
    for (int it = 0; it < 2; ++it) { const int item = tid + it * NTHR, j = item >> 3, pc = item & 7, dd = pc * 8;
        const u16* rp = proj + (size_t)(t0 + j) * INC + col0 + dd;
        const u32x4 a = *(const u32x4*)rp, b = *(const u32x4*)(rp + 64);
        const f32x4* cs = (const f32x4*)(rope + (size_t)(pos0 + j) * 64 + dd);
        const f32x4 c0 = cs[0], c1 = cs[1], c2 = cs[2], c3 = cs[3];
        const float sc = kdec ? scale * __expf((float)(127 - j) * lg) : scale;
        float x1[8] = {bflo(a.x), bfhi(a.x), bflo(a.y), bfhi(a.y), bflo(a.z), bfhi(a.z), bflo(a.w), bfhi(a.w)};
        float x2[8] = {bflo(b.x), bfhi(b.x), bflo(b.y), bfhi(b.y), bflo(b.z), bfhi(b.z), bflo(b.w), bfhi(b.w)};
        const float cc[8] = {c0[0], c0[2], c1[0], c1[2], c2[0], c2[2], c3[0], c3[2]};
        const float ss[8] = {c0[1], c0[3], c1[1], c1[3], c2[1], c2[3], c3[1], c3[3]};
        float o1[8], o2[8];
#pragma unroll
        for (int k = 0; k < 8; ++k) { o1[k] = (x1[k] * cc[k] - x2[k] * ss[k]) * sc; o2[k] = (x1[k] * ss[k] + x2[k] * cc[k]) * sc; }
        const int row = TRIMG ? trrow(j) : j;
        *LP(u32x4, dst + row * stride + dd * 2) = (u32x4){pack2(o1[0], o1[1]), pack2(o1[2], o1[3]), pack2(o1[4], o1[5]), pack2(o1[6], o1[7])};
        *LP(u32x4, dst + row * stride + (64 + dd) * 2) = (u32x4){pack2(o2[0], o2[1]), pack2(o2[2], o2[3]), pack2(o2[4], o2[5]), pack2(o2[6], o2[7])}; }
}
template <bool TRIMG>
DI void stage_plain(const Ctx& c, unsigned dst, int stride, int t0, int col0) {
    const u16* proj = (const u16*)(c.ws + WS_PROJ); const int tid = c.wid * 64 + lane_id();
#pragma unroll
    for (int it = 0; it < 4; ++it) { const int item = tid + it * NTHR, j = item >> 4, ch = item & 15;
        const u32x4 a = *(const u32x4*)(proj + (size_t)(t0 + j) * INC + col0 + ch * 8);
        const int row = TRIMG ? trrow(j) : j;
        *LP(u32x4, dst + row * stride + ch * 16) = a; }
}
DI bf16x8 tr_frag(unsigned img, int stride, int k0, int n0, int lane) {
    const int fq = lane >> 4, q = (lane & 15) >> 2, p = lane & 3;
    const int kb = k0 + 8 * fq, par = (kb >> 3) & 1;
    const unsigned a0 = img + (kb + ((par * 4) + q)) * stride + n0 * 2 + p * 8;
    const unsigned a1 = img + (kb + (((par ^ 1) * 4) + q)) * stride + n0 * 2 + p * 8;
    return cat8(tr_read(a0), tr_read(a1));
}
DI bf16x8 row_frag(unsigned img, int stride, int r0, int k0, int lane) {
    return *LP(const bf16x8, img + (r0 + (lane & 15)) * stride + (k0 + 8 * (lane >> 4)) * 2);
}

constexpr int RS = 272, TS = 288;
constexpr int IMG_R = 128 * RS, IMG_T = 128 * TS;

DI void ret_kv_unit(const Ctx& c, int u) {
    const int h = u & 7, n = (u >> 3) & 15, b = u >> 7;
    const int t0 = b * SEQ + n * CHUNK; const float lg = head_log_gamma(h);
    const unsigned base = (unsigned)(size_t)c.lds, Kimg = base, Vimg = base + IMG_T;
    __syncthreads();
    stage_rope<true>(c, Kimg, TS, t0, RW + h * 128, n * CHUNK, 0.08838834764831845f, lg, true);
    stage_plain<true>(c, Vimg, TS, t0, 2 * RW + h * 128);
    __syncthreads();
    f32x4 acc[8];
#pragma unroll
    for (int i = 0; i < 8; ++i) acc[i] = (f32x4){0.f, 0.f, 0.f, 0.f};
    const int d0 = c.wid * 16, lane = lane_id();
#pragma unroll
    for (int ks = 0; ks < 4; ++ks) { const bf16x8 kf = tr_frag(Kimg, TS, ks * 32, d0, lane);
#pragma unroll
        for (int ef = 0; ef < 8; ++ef) acc[ef] = MFMA16(tr_frag(Vimg, TS, ks * 32, ef * 16, lane), kf, acc[ef]); }
    u16* kv = (u16*)(c.ws + WS_KV) + (size_t)((b * NHEAD + h) * NCH + n) * 16384;
    const int d = d0 + (lane & 15), fq = lane >> 4;
#pragma unroll
    for (int ef = 0; ef < 8; ++ef) *(u32x2*)(kv + d * 128 + ef * 16 + 4 * fq) = pack4(acc[ef]);
}

DI void ret_cum_unit(const Ctx& c, int u) {
    const int bh = u >> 3, q = u & 7; const float cd = __expf(128.0f * head_log_gamma(bh & 7));
    const int tid = c.wid * 64 + lane_id();
    const u16* kv = (const u16*)(c.ws + WS_KV) + (size_t)(bh * NCH) * 16384 + q * 2048 + tid * 4;
    u16* kvc = (u16*)(c.ws + WS_KV) + (size_t)512 * 16384 + (size_t)(bh * NCH) * 16384 + q * 2048 + tid * 4;
    u32x2 v[NCH - 1];
#pragma unroll
    for (int m = 0; m < NCH - 1; ++m) v[m] = *(const u32x2*)(kv + (size_t)m * 16384);
    f32x4 s0 = {0.f, 0.f, 0.f, 0.f};
#pragma unroll
    for (int m = 0; m < NCH - 1; ++m) {
        s0 = s0 * cd + (f32x4){bflo(v[m].x), bfhi(v[m].x), bflo(v[m].y), bfhi(v[m].y)};
        *(u32x2*)(kvc + (size_t)(m + 1) * 16384) = pack4(s0); }
}

DI void ret_out_unit(const Ctx& c, int u) {
    const KPtr kp = kargs();
    const int h = u & 7, n = (u >> 3) & 15, b = u >> 7;
    const int t0 = b * SEQ + n * CHUNK; const float lg = head_log_gamma(h);
    const unsigned base = (unsigned)(size_t)c.lds, Qimg = base, Kimg = base + IMG_R, Vimg = base + 2 * IMG_R, Simg = base + 2 * IMG_R + IMG_T;
    const u16* proj = (const u16*)(c.ws + WS_PROJ);
    __syncthreads();
    u32x2 gbv[8]; f32x4 gwv[8];
    { const int l0 = lane_id(), il0 = 16 * c.wid + (l0 & 15), fq0 = l0 >> 4; const float* gnw0 = kp->in[3] + h * 128;
#pragma unroll
      for (int ef = 0; ef < 8; ++ef) { const int e = ef * 16 + 4 * fq0; gwv[ef] = *(const f32x4*)(gnw0 + e); gbv[ef] = *(const u32x2*)(proj + (size_t)(t0 + il0) * INC + 3 * RW + h * 128 + e); } }
    stage_rope<false>(c, Qimg, RS, t0, h * 128, n * CHUNK, 1.0f, lg, false);
    stage_rope<false>(c, Kimg, RS, t0, RW + h * 128, n * CHUNK, 0.08838834764831845f, lg, false);
    stage_plain<true>(c, Vimg, TS, t0, 2 * RW + h * 128);
    {
        const u32x2* sc = (const u32x2*)((const u16*)(c.ws + WS_KV) + (size_t)512 * 16384 + (size_t)((b * NHEAD + h) * NCH + n) * 16384); const int tid = c.wid * 64 + lane_id();
#pragma unroll
        for (int i = 0; i < 8; ++i) { const int idx = tid + i * NTHR, dd = idx >> 5, e4 = (idx & 31) * 4;
            const u32x2 sv = (n > 0) ? sc[idx] : (u32x2){0u, 0u};
            *LP(u32x2, Simg + trrow(dd) * TS + e4 * 2) = sv; }
    }
    __syncthreads();
    const int w = c.wid, lane = lane_id(), fq = lane >> 4, il = 16 * w + (lane & 15);
    bf16x8 qf[4];
#pragma unroll
    for (int ks = 0; ks < 4; ++ks) qf[ks] = row_frag(Qimg, RS, 16 * w, ks * 32, lane);
    f32x4 acc[8];
#pragma unroll
    for (int i = 0; i < 8; ++i) acc[i] = (f32x4){0.f, 0.f, 0.f, 0.f};
#pragma unroll
    for (int ks = 0; ks < 4; ++ks)
#pragma unroll
        for (int ef = 0; ef < 8; ++ef) acc[ef] = MFMA16(tr_frag(Simg, TS, ks * 32, ef * 16, lane), qf[ks], acc[ef]);
    { const float qd = __expf((float)(il + 1) * lg);
#pragma unroll
      for (int ef = 0; ef < 8; ++ef) acc[ef] *= qd; }
    f32x4 sc[8];
#pragma unroll
    for (int jf = 0; jf < 8; ++jf) { sc[jf] = (f32x4){0.f, 0.f, 0.f, 0.f};
        if (jf <= w) {
#pragma unroll
            for (int ks = 0; ks < 4; ++ks) sc[jf] = MFMA16(row_frag(Kimg, RS, jf * 16, ks * 32, lane), qf[ks], sc[jf]);
#pragma unroll
            for (int r = 0; r < 4; ++r) { const int j = jf * 16 + 4 * fq + r; sc[jf][r] = (il >= j) ? sc[jf][r] * __expf((float)(il - j) * lg) : 0.f; }
        } }
    __syncthreads();
    const unsigned Pimg = Kimg;
#pragma unroll
    for (int jf = 0; jf < 8; ++jf) *LP(u32x2, Pimg + il * RS + (jf * 16 + 4 * fq) * 2) = pack4(sc[jf]);
    __syncthreads();
#pragma unroll
    for (int ks = 0; ks < 4; ++ks) if (ks <= (w >> 1)) { const bf16x8 pf = row_frag(Pimg, RS, 16 * w, ks * 32, lane);
#pragma unroll
        for (int ef = 0; ef < 8; ++ef) acc[ef] = MFMA16(tr_frag(Vimg, TS, ks * 32, ef * 16, lane), pf, acc[ef]); }
    float s = 0.f;
#pragma unroll
    for (int ef = 0; ef < 8; ++ef) s += (acc[ef][0] + acc[ef][1]) + (acc[ef][2] + acc[ef][3]);
    s += __shfl_xor(s, 16); s += __shfl_xor(s, 32);
    const float mean = s * (1.0f / 128.0f); float qv = 0.f;
#pragma unroll
    for (int ef = 0; ef < 8; ++ef) { const f32x4 dlt = acc[ef] - mean; qv += (dlt[0] * dlt[0] + dlt[1] * dlt[1]) + (dlt[2] * dlt[2] + dlt[3] * dlt[3]); }
    qv += __shfl_xor(qv, 16); qv += __shfl_xor(qv, 32);
    const float rstd = rsqrtf(qv * (1.0f / 128.0f) + LN_EPS);
    u16* mixed = (u16*)(c.ws + WS_MIXED);
    const size_t trow = (size_t)(t0 + il);
#pragma unroll
    for (int ef = 0; ef < 8; ++ef) { const int e = ef * 16 + 4 * fq; const f32x4 gw = gwv[ef];
        const u32x2 gb = gbv[ef];
        const float g[4] = {bflo(gb.x), bfhi(gb.x), bflo(gb.y), bfhi(gb.y)}; f32x4 o;
#pragma unroll
        for (int r = 0; r < 4; ++r) o[r] = (acc[ef][r] - mean) * rstd * gw[r] * (g[r] * sigmoidf_(g[r]));
        *(u32x2*)(mixed + trow * D + h * 128 + e) = pack4(o); }
}

constexpr int LAS_STR = 132;
DI void lru_local_unit(const Ctx& c, int u) {
    const KPtr kp = kargs();
    const int blk = u & 7, n = (u >> 3) & 15, b = u >> 7;
    const int t0 = b * SEQ + n * CHUNK, cb = blk * 128;
    const unsigned base = (unsigned)(size_t)c.lds, Aimg = base, Waimg = base + IMG_R, Wximg = base + IMG_R + IMG_T;
    const u16* proj = (const u16*)(c.ws + WS_PROJ);
    const float* conv_w = kp->in[4]; const float* conv_b = kp->in[5];
    __syncthreads();
    {
        const float* wa = kp->in[6] + (size_t)blk * 16384; const float* wx = kp->in[8] + (size_t)blk * 16384;
        const int tid = c.wid * 64 + lane_id();
#pragma unroll
        for (int it = 0; it < 8; ++it) { const int item = tid + it * NTHR, i = item >> 5, jc = item & 31;
            *LP(u32x2, Waimg + trrow(i) * TS + jc * 8) = pack4(*(const f32x4*)(wa + i * 128 + jc * 4));
            *LP(u32x2, Wximg + trrow(i) * TS + jc * 8) = pack4(*(const f32x4*)(wx + i * 128 + jc * 4)); }
    }
    {
        const int tid = c.wid * 64 + lane_id(); const int tr = tid >> 4, cc = tid & 15, ch = cb + cc * 8;
        float xin[7][8];
#pragma unroll
        for (int rr = 0; rr < 7; ++rr) { const int tl = 4 * tr - 3 + rr;
            if (n == 0 && tl < 0) {
#pragma unroll
                for (int k = 0; k < 8; ++k) xin[rr][k] = 0.f;
            } else { const u32x4 v = *(const u32x4*)(proj + (size_t)(t0 + tl) * INC + 4 * RW + ch);
                xin[rr][0] = bflo(v.x); xin[rr][1] = bfhi(v.x); xin[rr][2] = bflo(v.y); xin[rr][3] = bfhi(v.y); xin[rr][4] = bflo(v.z); xin[rr][5] = bfhi(v.z); xin[rr][6] = bflo(v.w); xin[rr][7] = bfhi(v.w); } }
        float wv[4][8], bv[8];
#pragma unroll
        for (int j = 0; j < 4; ++j) { const f32x4 w0 = *(const f32x4*)(conv_w + j * LW + ch), w1 = *(const f32x4*)(conv_w + j * LW + ch + 4);
            wv[j][0] = w0[0]; wv[j][1] = w0[1]; wv[j][2] = w0[2]; wv[j][3] = w0[3]; wv[j][4] = w1[0]; wv[j][5] = w1[1]; wv[j][6] = w1[2]; wv[j][7] = w1[3]; }
        { const f32x4 b0 = *(const f32x4*)(conv_b + ch), b1 = *(const f32x4*)(conv_b + ch + 4); bv[0] = b0[0]; bv[1] = b0[1]; bv[2] = b0[2]; bv[3] = b0[3]; bv[4] = b1[0]; bv[5] = b1[1]; bv[6] = b1[2]; bv[7] = b1[3]; }
#pragma unroll
        for (int r = 0; r < 4; ++r) { float o[8];
#pragma unroll
            for (int k = 0; k < 8; ++k) o[k] = bv[k] + wv[0][k] * xin[r][k] + wv[1][k] * xin[r + 1][k] + wv[2][k] * xin[r + 2][k] + wv[3][k] * xin[r + 3][k];
            *LP(u32x4, Aimg + (4 * tr + r) * RS + cc * 16) = (u32x4){pack2(o[0], o[1]), pack2(o[2], o[3]), pack2(o[4], o[5]), pack2(o[6], o[7])}; }
    }
    __syncthreads();
    const int wr = c.wid >> 2, wc = c.wid & 3; int lane = lane_id(); int fr = lane & 15, fq = lane >> 4;
    f32x4 aR[4][2], aG[4][2];
    f32x4 bavv[2], bxvv[2], lmvv[2];
#pragma unroll
    for (int nn = 0; nn < 2; ++nn) { const int cl0 = cb + wc * 32 + nn * 16 + 4 * fq;
        bavv[nn] = *(const f32x4*)(kp->in[7] + cl0); bxvv[nn] = *(const f32x4*)(kp->in[9] + cl0); lmvv[nn] = *(const f32x4*)(kp->in[10] + cl0); }
#pragma unroll
    for (int m = 0; m < 4; ++m)
#pragma unroll
        for (int nn = 0; nn < 2; ++nn) { aR[m][nn] = (f32x4){0.f, 0.f, 0.f, 0.f}; aG[m][nn] = (f32x4){0.f, 0.f, 0.f, 0.f}; }
#pragma unroll
    for (int ks = 0; ks < 4; ++ks) { bf16x8 xf[4];
#pragma unroll
        for (int m = 0; m < 4; ++m) xf[m] = row_frag(Aimg, RS, wr * 64 + m * 16, ks * 32, lane);
#pragma unroll
        for (int nn = 0; nn < 2; ++nn) { const bf16x8 fa = tr_frag(Waimg, TS, ks * 32, wc * 32 + nn * 16, lane), fx = tr_frag(Wximg, TS, ks * 32, wc * 32 + nn * 16, lane);
#pragma unroll
            for (int m = 0; m < 4; ++m) { aR[m][nn] = MFMA16(fa, xf[m], aR[m][nn]); aG[m][nn] = MFMA16(fx, xf[m], aG[m][nn]); } } }
    u32x2 xcv[2][4];
#pragma unroll
    for (int nn = 0; nn < 2; ++nn)
#pragma unroll
        for (int m = 0; m < 4; ++m) xcv[nn][m] = *LP(const u32x2, Aimg + (wr * 64 + m * 16 + fr) * RS + (wc * 32 + nn * 16 + 4 * fq) * 2);
    __syncthreads();
    lane = lane_id(); fr = lane & 15; fq = lane >> 4;
    LAS float* LA = (LAS float*)c.lds; LAS float* LB = LA + 128 * LAS_STR;
#pragma unroll
    for (int nn = 0; nn < 2; ++nn) { const int cl = wc * 32 + nn * 16 + 4 * fq;
        const f32x4 bav = bavv[nn], bxv = bxvv[nn], lmv = lmvv[nn];
        f32x4 lsg;
#pragma unroll
        for (int r = 0; r < 4; ++r) lsg[r] = -log1pf(__expf(-lmv[r]));
#pragma unroll
        for (int m = 0; m < 4; ++m) { const int tl = wr * 64 + m * 16 + fr;
            const f32x4 xc = {bflo(xcv[nn][m].x), bfhi(xcv[nn][m].x), bflo(xcv[nn][m].y), bfhi(xcv[nn][m].y)};
            f32x4 av, bvv;
#pragma unroll
            for (int r = 0; r < 4; ++r) { const float rg = sigmoidf_(aR[m][nn][r] + bav[r]), gi = sigmoidf_(aG[m][nn][r] + bxv[r]);
                const float la = 8.0f * rg * lsg[r]; av[r] = __expf(la); bvv[r] = __builtin_amdgcn_sqrtf(fmaxf(1.0f - av[r] * av[r], 0.f)) * (gi * xc[r]); }
            *(LAS f32x4*)(LA + tl * LAS_STR + cl) = av; *(LAS f32x4*)(LB + tl * LAS_STR + cl) = bvv; } }
    __syncthreads();
    LAS float* SEGA = LB + 128 * LAS_STR;
    LAS float* SEGH = SEGA + 512;
    const int tid2 = c.wid * 64 + lane_id(); const int ch = tid2 & 127, sg = tid2 >> 7;
    { float A = 1.f, H = 0.f;
#pragma unroll 8
      for (int t = sg * 32; t < sg * 32 + 32; ++t) { const float a = LA[t * LAS_STR + ch], bb = LB[t * LAS_STR + ch]; H = a * H + bb; A *= a; LA[t * LAS_STR + ch] = A; LB[t * LAS_STR + ch] = H; }
      SEGA[sg * 128 + ch] = A; SEGH[sg * 128 + ch] = H; }
    __syncthreads();
    { float Ain = 1.f, Hin = 0.f;
      for (int s2 = 0; s2 < sg; ++s2) { const float a = SEGA[s2 * 128 + ch], hh = SEGH[s2 * 128 + ch]; Hin = a * Hin + hh; Ain *= a; }
      float A = 1.f, H = 0.f;
#pragma unroll 8
      for (int t = sg * 32; t < sg * 32 + 32; ++t) { const float la = LA[t * LAS_STR + ch]; A = la * Ain; H = LB[t * LAS_STR + ch] + la * Hin;
          LA[t * LAS_STR + ch] = A; LB[t * LAS_STR + ch] = H; }
      if (sg == 3) { ((float*)(c.ws + WS_CA))[(b * NCH + n) * LW + cb + ch] = A; ((float*)(c.ws + WS_CH))[(b * NCH + n) * LW + cb + ch] = H; } }
    __syncthreads();
    { u16* acum = (u16*)(c.ws + WS_ACUM); u16* hloc = (u16*)(c.ws + WS_HLOC);
#pragma unroll
      for (int it = 0; it < 4; ++it) { const int item = tid2 + it * NTHR, t = item >> 4, c8 = (item & 15) * 8;
          const f32x4 a0 = *(const LAS f32x4*)(LA + t * LAS_STR + c8), a1 = *(const LAS f32x4*)(LA + t * LAS_STR + c8 + 4);
          const f32x4 h0 = *(const LAS f32x4*)(LB + t * LAS_STR + c8), h1 = *(const LAS f32x4*)(LB + t * LAS_STR + c8 + 4);
          const u32x2 al = pack4(a0), ah = pack4(a1), hl = pack4(h0), hh = pack4(h1);
          *(u32x4*)(acum + (size_t)(t0 + t) * LW + cb + c8) = (u32x4){al.x, al.y, ah.x, ah.y};
          *(u32x4*)(hloc + (size_t)(t0 + t) * LW + cb + c8) = (u32x4){hl.x, hl.y, hh.x, hh.y}; } }
}

DI void lru_fin_unit(const Ctx& c, int u) {
    const int blk = u & 7, n = (u >> 3) & 15, b = u >> 7;
    const int t0 = b * SEQ + n * CHUNK, cb = blk * 128;
    LAS float* hin = (LAS float*)c.lds; const int tid = c.wid * 64 + lane_id();
    __syncthreads();
    if (tid < 128) { const float* ca = (const float*)(c.ws + WS_CA) + (size_t)b * NCH * LW + cb + tid; const float* chh = (const float*)(c.ws + WS_CH) + (size_t)b * NCH * LW + cb + tid;
        float av[NCH - 1], hv[NCH - 1];
#pragma unroll
        for (int m = 0; m < NCH - 1; ++m) { const int mm = m < n ? m : 0; av[m] = ca[mm * LW]; hv[m] = chh[mm * LW]; }
        float hcar = 0.f;
#pragma unroll
        for (int m = 0; m < NCH - 1; ++m) hcar = (m < n) ? av[m] * hcar + hv[m] : hcar;
        hin[tid] = hcar; }
    __syncthreads();
    const u16* acum = (const u16*)(c.ws + WS_ACUM); const u16* hloc = (const u16*)(c.ws + WS_HLOC); const u16* proj = (const u16*)(c.ws + WS_PROJ); u16* mixed = (u16*)(c.ws + WS_MIXED);
#pragma unroll
    for (int it = 0; it < 8; ++it) { const int item = tid + it * NTHR, t = item >> 5, c4 = (item & 31) * 4;
        const size_t o = (size_t)(t0 + t) * LW + cb + c4;
        const u32x2 ar = *(const u32x2*)(acum + o), hr = *(const u32x2*)(hloc + o);
        const f32x4 a = {bflo(ar.x), bfhi(ar.x), bflo(ar.y), bfhi(ar.y)}, hl = {bflo(hr.x), bfhi(hr.x), bflo(hr.y), bfhi(hr.y)}, hi4 = *(const LAS f32x4*)(hin + c4);
        const u32x2 yb = *(const u32x2*)(proj + (size_t)(t0 + t) * INC + 5 * RW + cb + c4);
        const float yg[4] = {bflo(yb.x), bfhi(yb.x), bflo(yb.y), bfhi(yb.y)}; f32x4 ov;
#pragma unroll
        for (int r = 0; r < 4; ++r) ov[r] = gelu_tanh(yg[r]) * (hl[r] + a[r] * hi4[r]);
        *(u32x2*)(mixed + (size_t)(t0 + t) * D + RW + cb + c4) = pack4(ov); }
}

constexpr int XSTR = 4112;
DI void p4_ln_router(const Ctx& c) {
    const KPtr kp = kargs();
    const int lane = lane_id(), w = c.wid, fq = lane >> 4, fr = lane & 15, tid = c.wid * 64 + lane;
    const unsigned base = (unsigned)(size_t)c.lds, Xhi = base, Xlo = base + 16 * XSTR;
    LAS float* red = (LAS float*)c.lds;
    LAS float* logit = (LAS float*)(c.lds + 135168);
    LAS int* sel_e = (LAS int*)(c.lds + 135168 + 4096);
    LAS float* sel_g = (LAS float*)(c.lds + 135168 + 4096 + 512);
    LAS int* sel_p = (LAS int*)(c.lds + 135168 + 4096 + 1024);
    LAS unsigned* lcnt = (LAS unsigned*)(c.lds + 135168 + 4096 + 1536);
    LAS unsigned* gbase = lcnt + 32;
    const u16* y1 = (const u16*)(c.ws + WS_Y1); const float* lw = kp->in[12]; const float* lb = kp->in[13];
    const float* wr_ = kp->in[14]; const float* br_ = kp->in[15];
    u16* x1b = (u16*)(c.ws + WS_X1B); float* st1 = (float*)(c.ws + WS_ST1);
    for (int tb = c.bid; tb < T / 32; tb += c.G) {
    __syncthreads();
    if (tid < 32) lcnt[tid] = 0u;
    const int tokbase = tb * 32;
    for (int pass = 0; pass < 2; ++pass) {
        __syncthreads();
        for (int tt = 0; tt < 2; ++tt) { const int tl = 2 * w + tt, tok = tokbase + pass * 16 + tl;
            const u32x2* src = (const u32x2*)(y1 + (size_t)tok * D); f32x4 v[8]; float s = 0.f;
#pragma unroll
            for (int i = 0; i < 8; ++i) { const u32x2 yv = src[i * 64 + lane]; v[i] = (f32x4){bflo(yv.x), bfhi(yv.x), bflo(yv.y), bfhi(yv.y)}; s += (v[i][0] + v[i][1]) + (v[i][2] + v[i][3]); }
#pragma unroll
            for (int o = 32; o >= 1; o >>= 1) s += __shfl_xor(s, o);
            const float mean = s * (1.0f / D); float qv = 0.f;
#pragma unroll
            for (int i = 0; i < 8; ++i) { const f32x4 dl = v[i] - mean; qv += (dl[0] * dl[0] + dl[1] * dl[1]) + (dl[2] * dl[2] + dl[3] * dl[3]); }
#pragma unroll
            for (int o = 32; o >= 1; o >>= 1) qv += __shfl_xor(qv, o);
            const float rstd = rsqrtf(qv * (1.0f / D) + LN_EPS);
            if (lane == 0) { st1[2 * tok] = mean; st1[2 * tok + 1] = rstd; }
#pragma unroll
            for (int i = 0; i < 8; ++i) { const int d = (i * 64 + lane) * 4; const f32x4 g = *(const f32x4*)(lw + d), bb = *(const f32x4*)(lb + d);
                const f32x4 xv = (v[i] - mean) * rstd * g + bb;
                const u32x2 hi = pack4(xv); const f32x4 rsd = {xv[0] - bflo(hi.x), xv[1] - bfhi(hi.x), xv[2] - bflo(hi.y), xv[3] - bfhi(hi.y)};
                *(u32x2*)(x1b + (size_t)tok * D + d) = hi;
                *LP(u32x2, Xhi + tl * XSTR + d * 2) = hi; *LP(u32x2, Xlo + tl * XSTR + d * 2) = pack4(rsd); } }
        __syncthreads();
        f32x4 acc[2] = {(f32x4){0.f, 0.f, 0.f, 0.f}, (f32x4){0.f, 0.f, 0.f, 0.f}};
#pragma unroll 2
        for (int ks = 0; ks < 8; ++ks) { const int k0 = 256 * w + 32 * ks + 8 * fq;
            const bf16x8 xh = *LP(const bf16x8, Xhi + fr * XSTR + k0 * 2), xl = *LP(const bf16x8, Xlo + fr * XSTR + k0 * 2);
#pragma unroll
            for (int nf = 0; nf < 2; ++nf) {
                float v[8]; const int e = nf * 16 + fr;
#pragma unroll
                for (int j = 0; j < 8; ++j) v[j] = wr_[(size_t)(k0 + j) * NE + e];
                unsigned hw[4], lwv[4];
#pragma unroll
                for (int j = 0; j < 4; ++j) { hw[j] = pack2(v[2 * j], v[2 * j + 1]); lwv[j] = pack2(v[2 * j] - bflo(hw[j]), v[2 * j + 1] - bfhi(hw[j])); }
                const bf16x8 wh = __builtin_bit_cast(bf16x8, (u32x4){hw[0], hw[1], hw[2], hw[3]}), wl = __builtin_bit_cast(bf16x8, (u32x4){lwv[0], lwv[1], lwv[2], lwv[3]});
                acc[nf] = MFMA16(wh, xh, acc[nf]); acc[nf] = MFMA16(wh, xl, acc[nf]); acc[nf] = MFMA16(wl, xh, acc[nf]); } }
        __syncthreads();
#pragma unroll
        for (int nf = 0; nf < 2; ++nf)
#pragma unroll
            for (int r = 0; r < 4; ++r) red[(w * 16 + fr) * 32 + nf * 16 + 4 * fq + r] = acc[nf][r];
        __syncthreads();
        { const int tl = tid >> 5, e = tid & 31; float s = br_[e];
#pragma unroll
          for (int ww = 0; ww < 8; ++ww) s += red[(ww * 16 + tl) * 32 + e];
          logit[(pass * 16 + tl) * 32 + e] = s; }
    }
    __syncthreads();
    if (tid < 32) { float l[32];
#pragma unroll
        for (int e = 0; e < 32; ++e) l[e] = logit[tid * 32 + e];
        float tv[4]; int te[4];
#pragma unroll
        for (int k = 0; k < 4; ++k) { float best = -3.0e38f; int bi = 0;
#pragma unroll
            for (int e = 0; e < 32; ++e) { const bool tk = l[e] > best; best = tk ? l[e] : best; bi = tk ? e : bi; }
            tv[k] = best; te[k] = bi;
#pragma unroll
            for (int e = 0; e < 32; ++e) l[e] = (e == bi) ? -3.0e38f : l[e]; }
        float ex[4], sum = 0.f;
#pragma unroll
        for (int k = 0; k < 4; ++k) { ex[k] = __expf(tv[k] - tv[0]); sum += ex[k]; }
        const float inv = 1.0f / sum;
#pragma unroll
        for (int k = 0; k < 4; ++k) { sel_e[tid * 4 + k] = te[k]; sel_g[tid * 4 + k] = ex[k] * inv; sel_p[tid * 4 + k] = (int)atomicAdd((unsigned*)&lcnt[te[k]], 1u); } }
    __syncthreads();
    { const int t2 = c.wid * 64 + lane_id(); if (t2 < 32) gbase[t2] = lcnt[t2] ? atomicAdd(c.ctl + CW_CNT + 64 * t2, lcnt[t2]) : 0u; }
    __syncthreads();
    { const int t3 = c.wid * 64 + lane_id(); if (t3 < 128) { const int e = sel_e[t3]; const int slot = (int)gbase[e] + sel_p[t3];
        int* lid = (int*)(c.ws + WS_LID); float* lgt = (float*)(c.ws + WS_LGT);
        lid[e * LIST_CAP + slot] = (tokbase + (t3 >> 2)) * 4 + (t3 & 3); lgt[e * LIST_CAP + slot] = sel_g[t3]; } }
    }
}

DI void p7_ln2(const Ctx& c) {
    const KPtr kp = kargs();
    const int lane = lane_id();
    const u16* y1 = (const u16*)(c.ws + WS_Y1); const float* st1 = (const float*)(c.ws + WS_ST1); const u16* yb = (const u16*)(c.ws + WS_YBUF);
    const float* l1w = kp->in[12]; const float* l1b = kp->in[13]; const float* l2w = kp->in[22]; const float* l2b = kp->in[23];
    u16* x2b = (u16*)(c.ws + WS_X2B); const float* ssq = (const float*)(c.ws + WS_SSQ); float* rse = (float*)(c.ws + WS_RSE);
    for (int tb = c.bid; tb < T / 32; tb += c.G)
    for (int tt = 0; tt < 4; ++tt) { const int tok = tb * 32 + c.wid * 4 + tt;
        const float mean1 = st1[2 * tok], rstd1 = st1[2 * tok + 1];
        f32x4 z[8]; float s = 0.f;
#pragma unroll
        for (int i = 0; i < 4; ++i) { const int d = (i * 64 + lane) * 8; const u32x4 yr = *(const u32x4*)(y1 + (size_t)tok * D + d);
            const f32x4 y0 = {bflo(yr.x), bfhi(yr.x), bflo(yr.y), bfhi(yr.y)}, y1v = {bflo(yr.z), bfhi(yr.z), bflo(yr.w), bfhi(yr.w)};
            const f32x4 g0 = *(const f32x4*)(l1w + d), g1 = *(const f32x4*)(l1w + d + 4), b0 = *(const f32x4*)(l1b + d), b1 = *(const f32x4*)(l1b + d + 4);
            f32x4 a0 = ((y0 - mean1) * rstd1 * g0 + b0) * DN_ALPHA, a1 = ((y1v - mean1) * rstd1 * g1 + b1) * DN_ALPHA;
#pragma unroll
            for (int k = 0; k < 4; ++k) { const u32x4 v = *(const u32x4*)(yb + ((size_t)tok * 4 + k) * D + d);
                a0[0] += bflo(v.x); a0[1] += bfhi(v.x); a0[2] += bflo(v.y); a0[3] += bfhi(v.y); a1[0] += bflo(v.z); a1[1] += bfhi(v.z); a1[2] += bflo(v.w); a1[3] += bfhi(v.w); }
            z[2 * i] = a0; z[2 * i + 1] = a1; s += ((a0[0] + a0[1]) + (a0[2] + a0[3])) + ((a1[0] + a1[1]) + (a1[2] + a1[3])); }
#pragma unroll
        for (int o = 32; o >= 1; o >>= 1) s += __shfl_xor(s, o);
        const float mean = s * (1.0f / D); float qv = 0.f;
#pragma unroll
        for (int i = 0; i < 8; ++i) { const f32x4 dl = z[i] - mean; qv += (dl[0] * dl[0] + dl[1] * dl[1]) + (dl[2] * dl[2] + dl[3] * dl[3]); }
#pragma unroll
        for (int o = 32; o >= 1; o >>= 1) qv += __shfl_xor(qv, o);
        const float rstd = rsqrtf(qv * (1.0f / D) + LN_EPS);
#pragma unroll
        for (int i = 0; i < 4; ++i) { const int d = (i * 64 + lane) * 8;
            const f32x4 g0 = *(const f32x4*)(l2w + d), g1 = *(const f32x4*)(l2w + d + 4), b0 = *(const f32x4*)(l2b + d), b1 = *(const f32x4*)(l2b + d + 4);
            const u32x2 lo = pack4((z[2 * i] - mean) * rstd * g0 + b0), hi = pack4((z[2 * i + 1] - mean) * rstd * g1 + b1);
            *(u32x4*)(x2b + (size_t)tok * D + d) = (u32x4){lo.x, lo.y, hi.x, hi.y}; }
        float q2 = (lane < 32) ? ssq[(size_t)tok * 32 + lane] : 0.f;
#pragma unroll
        for (int o = 32; o >= 1; o >>= 1) q2 += __shfl_xor(q2, o);
        if (lane == 0) rse[tok] = rsqrtf(q2 * (1.0f / D) + LN_EPS); }
}

__global__ void __launch_bounds__(NTHR, 2) hybrid_fwd(Params P) {
    extern __shared__ __attribute__((aligned(16))) unsigned char lds_raw[];
    Ctx c; c.lds = (LAS unsigned char*)lds_raw; c.ws = P.ws; c.ctl = (unsigned*)(P.ws + WS_CTL);
    c.wid = __builtin_amdgcn_readfirstlane(threadIdx.x >> 6); c.bid = blockIdx.x; c.G = gridDim.x;
    volatile LAS unsigned* xbw = (volatile LAS unsigned*)(c.lds + LDS_BYTES - 16);
    if (threadIdx.x == 0) { xbw[0] = 0u; xbw[1] = 0u; xbw[2] = 0u; xbw[3] = 0u; }
    __syncthreads();
    const XcdBarrier bar = xcd_barrier_post(c.ctl, xbw);

#ifndef PHMASK
#define PHMASK 0xFFFF
#endif
#define PH(k) if ((PHMASK >> (k)) & 1)
#ifndef DBLMASK
#define DBLMASK 0
#endif
#define DBL(k) if ((DBLMASK >> (k)) & 1)
    PH(0) p0_prologue(c);
    DBL(0) p0_prologue(c);
    xcd_barrier(bar);
    PH(1) p1_gemm(c);
    DBL(1) p1_gemm(c);
    xcd_barrier(bar);
    PH(2) for (int u = c.bid; u < 512; u += c.G) ret_kv_unit(c, u);
    PH(3) for (int u = c.bid; u < 512; u += c.G) lru_local_unit(c, u);
    DBL(2) for (int u = c.bid; u < 512; u += c.G) ret_kv_unit(c, u);
    DBL(3) for (int u = c.bid; u < 512; u += c.G) lru_local_unit(c, u);
    xcd_barrier(bar);
    for (int u = c.bid; u < 256; u += c.G) ret_cum_unit(c, u);
    xcd_barrier(bar);
    PH(4) for (int u = c.bid, k = 0; u < 512; u += c.G, ++k) ret_out_unit(c, (c.G == 256 && (k & 1)) ? (u ^ (15 << 3)) : u);
    PH(5) for (int u = c.bid, k = 0; u < 512; u += c.G, ++k) lru_fin_unit(c, (c.G == 256 && (k & 1)) ? (u ^ (15 << 3)) : u);
    DBL(4) for (int u = c.bid; u < 512; u += c.G) ret_out_unit(c, u);
    DBL(5) for (int u = c.bid; u < 512; u += c.G) lru_fin_unit(c, u);
    xcd_barrier(bar);
    PH(6) p3_gemm(c);
    DBL(6) p3_gemm(c);
    xcd_barrier(bar);
    PH(7) p4_ln_router(c);
    xcd_barrier(bar);
    PH(8) p5_moe_up(c);
    DBL(8) p5_moe_up(c);
    xcd_barrier(bar);
    PH(9) { p6_moe_down(c); ple_gemm(c); }
    DBL(9) p6_moe_down(c);
    xcd_barrier(bar);
    PH(10) p7_ln2(c);
    DBL(10) p7_ln2(c);
    xcd_barrier(bar);
    PH(11) p8_gemm(c);
}
}

extern "C" void kernel_launch(void* const* d_in, const int* in_sizes, int n_in, void* d_out, int out_size, void* d_ws, size_t ws_size, hipStream_t stream) {
    static int grid = 0;
    if (grid == 0) {
        int dev = 0, cus = 0, per_cu = 0;
        if (n_in != 27 || ws_size < WS_END) { grid = -1; return; }
        if (hipGetDevice(&dev) != hipSuccess || hipDeviceGetAttribute(&cus, hipDeviceAttributeMultiprocessorCount, dev) != hipSuccess) { grid = -1; return; }
        if (hipFuncSetAttribute((const void*)hybrid_fwd, hipFuncAttributeMaxDynamicSharedMemorySize, LDS_BYTES) != hipSuccess) { grid = -1; return; }
        (void)hipOccupancyMaxActiveBlocksPerMultiprocessor(&per_cu, (const void*)hybrid_fwd, NTHR, LDS_BYTES);
        (void)hipGetLastError();
        if (per_cu < 1) { grid = -1; return; }
        grid = (cus / 8) * 8;
        if (grid > 256) grid = 256;
    }
    if (grid <= 0) return;
    (void)in_sizes; (void)out_size;
    (void)hipMemsetAsync((char*)d_ws + WS_CTL, 0, CTL_BYTES, stream);
    Params p{};
    for (int i = 0; i < 27; ++i) p.in[i] = (const float*)d_in[i];
    p.out = (float*)d_out; p.ws = (unsigned char*)d_ws;
    hipLaunchKernelGGL(hybrid_fwd, dim3(grid), dim3(NTHR), LDS_BYTES, stream, p);
}
```
